# Optimizing an MI355X kernel written in HIP

```python
import math
import jax, jax.numpy as jnp
from jax import lax
import numpy as np

D_MODEL = 1024
BATCH = 4
SEQ = 4096
DEPTH = 4

GRID_W = 64
CTX_LEN = 256

N_DIFF_HEADS = 4
DIFF_QK_DIM = 64
DIFF_V_DIM = 2 * DIFF_QK_DIM
DIFF_WIDTH = N_DIFF_HEADS * DIFF_V_DIM
CONV_WIDTH = D_MODEL - DIFF_WIDTH
SHORT_CONV_K = 3
Q_BLOCK = 128
ROPE_BASE = 10000.0
AB_IN_COLS = 3 * DIFF_WIDTH + 3 * CONV_WIDTH

SSD_D_INNER = 2 * D_MODEL
SSD_HEAD_DIM = 64
SSD_HEADS = SSD_D_INNER // SSD_HEAD_DIM
SSD_GROUPS = 4
SSD_STATE = 128
SSD_CONV_K = 3
SSD_CHUNK = 128
SSD_CONV_CH = SSD_D_INNER + 2 * SSD_GROUPS * SSD_STATE
SSD_IN_COLS = SSD_D_INNER + SSD_CONV_CH + 2 * SSD_HEADS

MOE_GROUPS = 4
MOE_EXPERTS_PER_GROUP = 8
MOE_EXPERTS = MOE_GROUPS * MOE_EXPERTS_PER_GROUP
MOE_TOP_K = 2
MOE_HIDDEN = 512
MOE_BLOCK = 128

kernel_name = 'hybrid_diffattn_shortconv_ssd_hmoe_prefix'


def rms_norm(x, g, eps=1e-6):
    xf = x.astype(jnp.float32)
    y = xf * lax.rsqrt(jnp.mean(xf * xf, axis=-1, keepdims=True) + eps)
    return (y * g.astype(jnp.float32)).astype(x.dtype)


def modulate(h, shift, scale):
    return h * (1 + scale) + shift


def dwconv_centred(u, w):
    k = w.shape[0]
    return lax.conv_general_dilated(u, w[:, None, :], window_strides=(1,),
                                    padding=((k // 2, k // 2),),
                                    dimension_numbers=('NWC', 'WIO', 'NWC'),
                                    feature_group_count=u.shape[-1])


def axial_rope_tables(n):
    rows = n // GRID_W
    row = jnp.broadcast_to(jnp.arange(rows, dtype=jnp.float32)[:, None], (rows, GRID_W)).reshape(n)
    col = jnp.broadcast_to(jnp.arange(GRID_W, dtype=jnp.float32)[None, :], (rows, GRID_W)).reshape(n)
    axis_dim = DIFF_QK_DIM // 2
    inv_freq = ROPE_BASE ** (-jnp.arange(0, axis_dim, 2, dtype=jnp.float32) / axis_dim)
    ang = jnp.stack([row[:, None] * inv_freq, col[:, None] * inv_freq], axis=1)
    return jnp.cos(ang), jnp.sin(ang)


def apply_axial_rope(x, cos, sin):
    xf = x.astype(jnp.float32).reshape(*x.shape[:-1], 2, 2, DIFF_QK_DIM // 4)
    x1, x2 = xf[..., 0, :], xf[..., 1, :]
    c = cos[None, :, None, None]
    s = sin[None, :, None, None]
    out = jnp.stack([x1 * c - x2 * s, x2 * c + x1 * s], axis=-2)
    return out.reshape(x.shape).astype(x.dtype)


def diff_attend(q, k, v, lam):
    s = jnp.einsum('bqhcd,bkhcd->bhcqk', q, k).astype(jnp.float32) * (DIFF_QK_DIM ** -0.5)
    p = jax.nn.softmax(s, axis=-1)
    pd = p[:, :, 0] - lam * p[:, :, 1]
    return jnp.einsum('bhqk,bkhd->bqhd', pd.astype(v.dtype), v)


def attn_conv_mixer(h_lat, h_ctx, w_in, w_out, lq1, lk1, lq2, lk2, subln_g, conv_w, layer_idx):
    lam_init = 0.8 - 0.6 * math.exp(-0.3 * layer_idx)
    f32 = jnp.float32
    lam = (jnp.exp(jnp.sum(lq1.astype(f32) * lk1.astype(f32)))
           - jnp.exp(jnp.sum(lq2.astype(f32) * lk2.astype(f32))) + lam_init)

    def project(h):
        b, n = h.shape[:2]
        q, k, v, gb, gc, xc = jnp.split(h @ w_in, [DIFF_WIDTH, 2 * DIFF_WIDTH, 3 * DIFF_WIDTH,
                                                   3 * DIFF_WIDTH + CONV_WIDTH,
                                                   3 * DIFF_WIDTH + 2 * CONV_WIDTH], axis=-1)
        q = q.reshape(b, n, N_DIFF_HEADS, 2, DIFF_QK_DIM)
        k = k.reshape(b, n, N_DIFF_HEADS, 2, DIFF_QK_DIM)
        v = v.reshape(b, n, N_DIFF_HEADS, DIFF_V_DIM)
        conv_out = gb * dwconv_centred(gc * xc, conv_w)
        return q, k, v, conv_out

    def finish(o, conv_out):
        o = rms_norm(o, subln_g) * (1 - lam_init)
        o = o.reshape(*o.shape[:2], DIFF_WIDTH)
        return jnp.concatenate([o, conv_out], axis=-1) @ w_out

    q_c, k_c, v_c, conv_c = project(h_ctx)
    o_c = diff_attend(q_c, k_c, v_c, lam)

    b, n = h_lat.shape[:2]
    q_l, k_l, v_l, conv_l = project(h_lat)
    cos, sin = axial_rope_tables(n)
    q_l = apply_axial_rope(q_l, cos, sin)
    k_l = apply_axial_rope(k_l, cos, sin)
    k_all = jnp.concatenate([k_c, k_l], axis=1)
    v_all = jnp.concatenate([v_c, v_l], axis=1)
    nb = n // Q_BLOCK
    qb = jnp.swapaxes(q_l.reshape(b, nb, Q_BLOCK, N_DIFF_HEADS, 2, DIFF_QK_DIM), 0, 1)
    o_l = lax.map(lambda qq: diff_attend(qq, k_all, v_all, lam), qb)
    o_l = jnp.swapaxes(o_l, 0, 1).reshape(b, n, N_DIFF_HEADS, DIFF_V_DIM)
    return finish(o_l, conv_l), finish(o_c, conv_c)


def ssd_chunked(x, dt, A, Bm, Cm, h0):
    b, L, H, P = x.shape
    G, N = Bm.shape[2], Bm.shape[3]
    E = H // G
    Q = SSD_CHUNK
    nc = L // Q
    f32 = jnp.float32
    xdt = (x.astype(f32) * dt[..., None]).reshape(b, nc, Q, G, E, P)
    a = (dt * A).reshape(b, nc, Q, G, E).transpose(0, 3, 4, 1, 2)
    a_cs = jnp.cumsum(a, axis=-1)
    Bc = Bm.astype(f32).reshape(b, nc, Q, G, N)
    Cc = Cm.astype(f32).reshape(b, nc, Q, G, N)
    lower = jnp.tril(jnp.ones((Q, Q), dtype=bool))
    seg = a_cs[..., :, None] - a_cs[..., None, :]
    Lmat = jnp.exp(jnp.where(lower, seg, -jnp.inf))
    CB = jnp.einsum('bclgn,bcsgn->bgcls', Cc, Bc)
    y_diag = jnp.einsum('bgcls,bgecls,bcsgep->bclgep', CB, Lmat, xdt)
    decay_to_end = jnp.exp(a_cs[..., -1:] - a_cs)
    chunk_states = jnp.einsum('bclgn,bgecl,bclgep->cbgepn', Bc, decay_to_end, xdt)
    chunk_decay = jnp.exp(a_cs[..., -1]).transpose(3, 0, 1, 2)

    def step(state, inp):
        dec, st = inp
        return state * dec[..., None, None] + st, state

    final, prev = lax.scan(step, h0.reshape(b, G, E, P, N), (chunk_decay, chunk_states))
    y_off = jnp.einsum('bclgn,cbgepn,bgecl->bclgep', Cc, prev, jnp.exp(a_cs))
    y = (y_diag + y_off).reshape(b, L, H, P)
    return y, final.reshape(b, H, P, N)


def ssd_mixer(h_lat, h_ctx, w_in, conv_w, conv_b, A_log, dt_bias, D_skip, norm_g, w_out):
    f32 = jnp.float32
    A = -jnp.exp(A_log.astype(f32))

    def prep(h):
        b, n = h.shape[:2]
        z, xbc, dt = jnp.split(h @ w_in, [SSD_D_INNER, SSD_D_INNER + SSD_CONV_CH], axis=-1)
        xbc = jax.nn.silu(dwconv_centred(xbc, conv_w) + conv_b)
        xs, Bm, Cm = jnp.split(xbc, [SSD_D_INNER, SSD_D_INNER + SSD_GROUPS * SSD_STATE], axis=-1)
        xs = xs.reshape(b, n, SSD_HEADS, SSD_HEAD_DIM)
        Bm = Bm.reshape(b, n, SSD_GROUPS, SSD_STATE)
        Cm = Cm.reshape(b, n, SSD_GROUPS, SSD_STATE)
        dt = jax.nn.softplus(dt.astype(f32).reshape(b, n, 2, SSD_HEADS) + dt_bias.astype(f32))
        return z, xs, Bm, Cm, dt

    def flip(t):
        return jnp.flip(t, axis=1)

    def bidir(xs, Bm, Cm, dt, h0_f, h0_b):
        y_f, s_f = ssd_chunked(xs, dt[:, :, 0], A[0], Bm, Cm, h0_f)
        y_b, s_b = ssd_chunked(flip(xs), flip(dt[:, :, 1]), A[1], flip(Bm), flip(Cm), h0_b)
        return y_f + flip(y_b), s_f, s_b

    def finish(z, xs, y):
        b, n = z.shape[:2]
        y = y + xs.astype(f32) * D_skip.astype(f32)[:, None]
        y = y.reshape(b, n, SSD_D_INNER) * jax.nn.silu(z.astype(f32))
        y = rms_norm(y.reshape(b, n, SSD_GROUPS, SSD_D_INNER // SSD_GROUPS),
                     norm_g.reshape(SSD_GROUPS, SSD_D_INNER // SSD_GROUPS))
        return y.reshape(b, n, SSD_D_INNER).astype(z.dtype) @ w_out

    z_c, x_c, B_c, C_c, dt_c = prep(h_ctx)
    zeros = jnp.zeros((h_ctx.shape[0], SSD_HEADS, SSD_HEAD_DIM, SSD_STATE), f32)
    y_c, s_cf, s_cb = bidir(x_c, B_c, C_c, dt_c, zeros, zeros)
    z_l, x_l, B_l, C_l, dt_l = prep(h_lat)
    y_l, _, _ = bidir(x_l, B_l, C_l, dt_l, s_cf, s_cb)
    return finish(z_l, x_l, y_l), finish(z_c, x_c, y_c)


def hier_moe(h, wg, bg, we, be, w_gate, w_up, w_down):
    T, D = h.shape
    gp = jax.nn.softmax((h @ wg + bg).astype(jnp.float32), axis=-1)
    g_idx = jnp.argmax(gp, axis=-1)
    g_w = jnp.max(gp, axis=-1)
    el = (h @ we + be).astype(jnp.float32).reshape(T, MOE_GROUPS, MOE_EXPERTS_PER_GROUP)
    el = jnp.take_along_axis(el, g_idx[:, None, None], axis=1)[:, 0]
    ep = jax.nn.softmax(el, axis=-1)
    top_p, top_i = lax.top_k(ep, MOE_TOP_K)
    wts = (g_w[:, None] * top_p / jnp.sum(top_p, axis=-1, keepdims=True)).reshape(-1)
    eid = (g_idx[:, None] * MOE_EXPERTS_PER_GROUP + top_i).reshape(-1).astype(jnp.int32)
    A = T * MOE_TOP_K
    tok = jnp.arange(A, dtype=jnp.int32) // MOE_TOP_K
    order = jnp.argsort(eid)
    s_eid, s_tok, s_w = eid[order], tok[order], wts[order]
    counts = jnp.bincount(eid, length=MOE_EXPERTS)
    start = jnp.cumsum(counts) - counts
    padded = (counts + MOE_BLOCK - 1) // MOE_BLOCK * MOE_BLOCK
    pend = jnp.cumsum(padded)
    dest = (pend - padded)[s_eid] + jnp.arange(A, dtype=jnp.int32) - start[s_eid]
    n_blocks = (A + MOE_EXPERTS * (MOE_BLOCK - 1)) // MOE_BLOCK
    slot_tok = jnp.zeros((n_blocks * MOE_BLOCK,), jnp.int32).at[dest].set(s_tok)
    slot_w = jnp.zeros((n_blocks * MOE_BLOCK,), jnp.float32).at[dest].set(s_w)
    block_eid = jnp.minimum(jnp.searchsorted(pend, jnp.arange(n_blocks) * MOE_BLOCK, side='right'),
                            MOE_EXPERTS - 1)
    xb = h[slot_tok].reshape(n_blocks, MOE_BLOCK, D)

    def expert_block(args):
        xblk, e = args
        return (jax.nn.silu(xblk @ w_gate[e]) * (xblk @ w_up[e])) @ w_down[e]

    yb = lax.map(expert_block, (xb, block_eid)).reshape(-1, D)
    return jnp.zeros_like(h).at[slot_tok].add(yb * slot_w[:, None].astype(h.dtype))


def setup_inputs(seed: int = 0) -> dict:
    key = jax.random.key(seed)
    ks = jax.random.split(key, 32)
    f32 = jnp.float32
    n_even = (DEPTH + 1) // 2
    n_odd = DEPTH // 2

    def nrm(k, shape, s):
        return jax.random.normal(k, shape, f32) * s

    def gain(k, shape):
        return 1.0 + 0.02 * jax.random.normal(k, shape, f32)

    dt0 = jnp.exp(jax.random.uniform(ks[20], (n_odd, 2, SSD_HEADS), f32,
                                     minval=math.log(1e-3), maxval=math.log(1e-1)))
    return {
        'x': nrm(ks[0], (BATCH, SEQ, D_MODEL), 1.0),
        'c': nrm(ks[1], (BATCH, D_MODEL), 1.0),
        'ctx': nrm(ks[2], (BATCH, CTX_LEN, D_MODEL), 1.0),
        'c_ctx': nrm(ks[3], (D_MODEL,), 1.0),
        'ada_w': nrm(ks[4], (DEPTH, D_MODEL, 6 * D_MODEL), 0.5 * D_MODEL ** -0.5),
        'ada_b': nrm(ks[5], (DEPTH, 6 * D_MODEL), 0.02),
        'norm1_g': gain(ks[6], (DEPTH, D_MODEL)),
        'norm2_g': gain(ks[7], (DEPTH, D_MODEL)),
        'ab_w_in': nrm(ks[8], (n_even, D_MODEL, AB_IN_COLS), D_MODEL ** -0.5),
        'ab_w_out': nrm(ks[9], (n_even, DIFF_WIDTH + CONV_WIDTH, D_MODEL), (DIFF_WIDTH + CONV_WIDTH) ** -0.5),
        'diff_lq1': nrm(ks[10], (n_even, DIFF_QK_DIM), 0.1),
        'diff_lk1': nrm(ks[11], (n_even, DIFF_QK_DIM), 0.1),
        'diff_lq2': nrm(ks[12], (n_even, DIFF_QK_DIM), 0.1),
        'diff_lk2': nrm(ks[13], (n_even, DIFF_QK_DIM), 0.1),
        'diff_subln_g': gain(ks[14], (n_even, DIFF_V_DIM)),
        'bconv_w': nrm(ks[15], (n_even, SHORT_CONV_K, CONV_WIDTH), SHORT_CONV_K ** -0.5),
        'ssd_w_in': nrm(ks[16], (n_odd, D_MODEL, SSD_IN_COLS), D_MODEL ** -0.5),
        'ssd_conv_w': nrm(ks[17], (n_odd, SSD_CONV_K, SSD_CONV_CH), SSD_CONV_K ** -0.5),
        'ssd_conv_b': nrm(ks[18], (n_odd, SSD_CONV_CH), 0.02),
        'ssd_A_log': jnp.log(jax.random.uniform(ks[19], (n_odd, 2, SSD_HEADS), f32, minval=1.0, maxval=16.0)),
        'ssd_dt_bias': dt0 + jnp.log(-jnp.expm1(-dt0)),
        'ssd_D': gain(ks[21], (n_odd, SSD_HEADS)),
        'ssd_norm_g': gain(ks[22], (n_odd, SSD_D_INNER)),
        'ssd_w_out': nrm(ks[23], (n_odd, SSD_D_INNER, D_MODEL), SSD_D_INNER ** -0.5),
        'moe_wg': nrm(ks[24], (DEPTH, D_MODEL, MOE_GROUPS), D_MODEL ** -0.5),
        'moe_bg': nrm(ks[25], (DEPTH, MOE_GROUPS), 0.01),
        'moe_we': nrm(ks[26], (DEPTH, D_MODEL, MOE_EXPERTS), D_MODEL ** -0.5),
        'moe_be': nrm(ks[27], (DEPTH, MOE_EXPERTS), 0.01),
        'moe_w_gate': nrm(ks[28], (DEPTH, MOE_EXPERTS, D_MODEL, MOE_HIDDEN), D_MODEL ** -0.5),
        'moe_w_up': nrm(ks[29], (DEPTH, MOE_EXPERTS, D_MODEL, MOE_HIDDEN), D_MODEL ** -0.5),
        'moe_w_down': nrm(ks[30], (DEPTH, MOE_EXPERTS, MOE_HIDDEN, D_MODEL), MOE_HIDDEN ** -0.5),
        'final_norm_g': gain(ks[31], (D_MODEL,)),
    }


def reference(x, c, ctx, c_ctx, ada_w, ada_b, norm1_g, norm2_g, ab_w_in, ab_w_out,
              diff_lq1, diff_lk1, diff_lq2, diff_lk2, diff_subln_g, bconv_w,
              ssd_w_in, ssd_conv_w, ssd_conv_b, ssd_A_log, ssd_dt_bias, ssd_D, ssd_norm_g, ssd_w_out,
              moe_wg, moe_bg, moe_we, moe_be, moe_w_gate, moe_w_up, moe_w_down, final_norm_g):
    x_lat, x_ctx = x, ctx
    b, n, d = x.shape
    silu_c = jax.nn.silu(c)
    silu_cc = jax.nn.silu(c_ctx)
    for layer in range(DEPTH):
        last = layer == DEPTH - 1
        mod_l = jnp.split((silu_c @ ada_w[layer] + ada_b[layer])[:, None, :], 6, axis=-1)
        mod_c = jnp.split(silu_cc @ ada_w[layer] + ada_b[layer], 6, axis=-1)
        h_lat = modulate(rms_norm(x_lat, norm1_g[layer]), mod_l[0], mod_l[1])
        h_ctx = modulate(rms_norm(x_ctx, norm1_g[layer]), mod_c[0], mod_c[1])
        if layer % 2 == 0:
            i = layer // 2
            m_lat, m_ctx = attn_conv_mixer(h_lat, h_ctx, ab_w_in[i], ab_w_out[i], diff_lq1[i], diff_lk1[i],
                                           diff_lq2[i], diff_lk2[i], diff_subln_g[i], bconv_w[i], layer)
        else:
            i = layer // 2
            m_lat, m_ctx = ssd_mixer(h_lat, h_ctx, ssd_w_in[i], ssd_conv_w[i], ssd_conv_b[i], ssd_A_log[i],
                                     ssd_dt_bias[i], ssd_D[i], ssd_norm_g[i], ssd_w_out[i])
        x_lat = x_lat + mod_l[2] * m_lat
        h2_lat = modulate(rms_norm(x_lat, norm2_g[layer]), mod_l[3], mod_l[4]).reshape(-1, d)
        moe_args = (moe_wg[layer], moe_bg[layer], moe_we[layer], moe_be[layer],
                    moe_w_gate[layer], moe_w_up[layer], moe_w_down[layer])
        if last:
            f_lat = hier_moe(h2_lat, *moe_args)
        else:
            x_ctx = x_ctx + mod_c[2] * m_ctx
            h2_ctx = modulate(rms_norm(x_ctx, norm2_g[layer]), mod_c[3], mod_c[4]).reshape(-1, d)
            f_all = hier_moe(jnp.concatenate([h2_lat, h2_ctx], axis=0), *moe_args)
            f_lat = f_all[:b * n]
            x_ctx = x_ctx + mod_c[5] * f_all[b * n:].reshape(x_ctx.shape)
        x_lat = x_lat + mod_l[5] * f_lat.reshape(b, n, d)
    return rms_norm(x_lat, final_norm_g)
```

```cpp
#ifndef CPU_EMU
#include <hip/hip_runtime.h>
#include <cstdio>
#include <cstdint>
#include <cstddef>
#include <cstring>
#define HD __host__ __device__ __forceinline__
#else
#include <cstdio>
#include <cstdint>
#include <cmath>
#include <cstring>
#include <cstddef>
#define HD inline
#endif

#ifdef TINY
constexpr int DM = 64, NB = 2, SEQ = 128, DEPTH = 4, GRID_W = 8, CTX = 64;
constexpr int NDH = 2, QKD = 8;
constexpr int SSD_P = 16, SSD_G = 2, SSD_N = 16;
constexpr int MOE_G = 2, MOE_EPG = 4, MOE_HID = 32;
constexpr int MOE_MT = 16;
constexpr int MOE_HB = 32;
constexpr int SSD_NP = 336;
#else
constexpr int DM = 1024, NB = 4, SEQ = 4096, DEPTH = 4, GRID_W = 64, CTX = 256;
constexpr int NDH = 4, QKD = 64;
constexpr int SSD_P = 64, SSD_G = 4, SSD_N = 128;
constexpr int MOE_G = 4, MOE_EPG = 8, MOE_HID = 512;
constexpr int MOE_MT = 256;
constexpr int MOE_HB = 128;
constexpr int SSD_NP = 5376;
#endif
constexpr int VD = 2 * QKD;
constexpr int DW = NDH * VD;
constexpr int CW = DM - DW;
constexpr int ABIN = 3 * DW + 3 * CW;
constexpr int SSD_DI = 2 * DM;
constexpr int SSD_H = SSD_DI / SSD_P;
constexpr int SSD_CC = SSD_DI + 2 * SSD_G * SSD_N;
constexpr int SSD_IN = SSD_DI + SSD_CC + 2 * SSD_H;
constexpr int SSD_E = SSD_H / SSD_G;
constexpr int MOE_E = MOE_G * MOE_EPG;
constexpr int TPB = CTX + SEQ;
constexpr int R = NB * TPB;
constexpr int NEVEN = (DEPTH + 1) / 2, NODD = DEPTH / 2;
constexpr int MAXSLOT = 2 * R + MOE_E * (MOE_MT - 1);
constexpr int NSLOT = (MAXSLOT + MOE_MT - 1) / MOE_MT * MOE_MT;
static_assert(SSD_NP >= SSD_IN, "pad");

typedef unsigned short bf16_t;
HD unsigned f2bf_u(float f) { unsigned u; memcpy(&u, &f, 4); return (u + 0x7fffu + ((u >> 16) & 1u)) >> 16; }
HD bf16_t f2bf(float f) { return (bf16_t)f2bf_u(f); }
HD float bf2f(bf16_t h) { unsigned u = ((unsigned)h) << 16; float f; memcpy(&f, &u, 4); return f; }
HD float siluf(float x) { return x / (1.f + expf(-x)); }
HD float softplusf(float x) { return x > 20.f ? x : log1pf(expf(x)); }

enum { I_X, I_C, I_CTX, I_CCTX, I_ADAW, I_ADAB, I_N1G, I_N2G, I_ABWIN, I_ABWOUT, I_LQ1, I_LK1, I_LQ2, I_LK2, I_SUBLN, I_BCONV,
       I_SSDWIN, I_SSDCW, I_SSDCB, I_SSDALOG, I_SSDDTB, I_SSDD, I_SSDNG, I_SSDWOUT, I_MWG, I_MBG, I_MWE, I_MBE, I_MWGATE, I_MWUP, I_MWDOWN, I_FNG, N_IN };

constexpr size_t al256(size_t x) { return (x + 255) / 256 * 256; }
constexpr size_t WS_CTL   = 0;
constexpr size_t CTL_BYTES = 1u << 20;
constexpr size_t WS_CNT   = WS_CTL + CTL_BYTES;
constexpr size_t WS_LAM   = al256(WS_CNT + (size_t)DEPTH * MOE_E * 4);
constexpr size_t WS_ROPE  = al256(WS_LAM + NEVEN * 4);
constexpr int WET_ROWS = 48;
constexpr size_t WS_WET   = al256(WS_ROPE + (size_t)GRID_W * (QKD / 4) * 2 * 4);
constexpr size_t WS_MODS  = al256(WS_WET + (size_t)DEPTH * 2 * WET_ROWS * DM * 2);
constexpr size_t WS_ROUTE = al256(WS_MODS + (size_t)DEPTH * (NB + 1) * 6 * DM * 4);
constexpr size_t WS_X     = al256(WS_ROUTE + (size_t)R * 32);
constexpr size_t WS_H     = al256(WS_X + (size_t)R * DM * 4);
constexpr size_t WS_WABIN = al256(WS_H + (size_t)R * DM * 2);
constexpr size_t WS_WABOUT= al256(WS_WABIN + (size_t)NEVEN * ABIN * DM * 2);
constexpr size_t WS_WSIN  = al256(WS_WABOUT + (size_t)NEVEN * DM * DM * 2);
constexpr size_t WS_WSOUT = al256(WS_WSIN + (size_t)NODD * SSD_NP * DM * 2);
constexpr size_t WS_W1    = al256(WS_WSOUT + (size_t)NODD * DM * SSD_DI * 2);
constexpr size_t WS_W2    = al256(WS_W1 + (size_t)MOE_E * 2 * MOE_HID * DM * 2);
constexpr size_t WS_BIG   = al256(WS_W2 + (size_t)MOE_E * DM * MOE_HID * 2);
constexpr size_t WS_QKVC  = WS_BIG;
constexpr size_t WS_O12   = al256(WS_QKVC + (size_t)R * ABIN * 2);
constexpr size_t WS_CAT   = al256(WS_O12 + (size_t)R * 2 * NDH * VD * 4);
constexpr size_t WS_EVEN_END = al256(WS_CAT + (size_t)R * DM * 2);
constexpr size_t WS_ZXD   = WS_BIG;
constexpr size_t WS_XBC   = al256(WS_ZXD + (size_t)R * SSD_NP * 2);
constexpr size_t WS_DT    = al256(WS_XBC + (size_t)R * SSD_CC * 2);
constexpr size_t WS_YS    = al256(WS_DT + (size_t)R * 2 * SSD_H * 4);
constexpr size_t WS_YN    = al256(WS_YS + (size_t)2 * R * SSD_DI * 2);
constexpr size_t WS_ODD_END = al256(WS_YN + (size_t)R * SSD_DI * 2);
constexpr size_t WS_XB    = WS_BIG;
constexpr size_t WS_ACT   = al256(WS_XB + (size_t)NSLOT * DM * 2);
constexpr size_t WS_YB    = al256(WS_ACT + (size_t)NSLOT * MOE_HID * 2);
constexpr size_t WS_LIST  = al256(WS_YB + (size_t)NSLOT * DM * 2);
constexpr int CAPL = 2 * R;
constexpr size_t WS_MOE_END = al256(WS_LIST + (size_t)MOE_E * CAPL * 4);
constexpr size_t WS_END   = WS_ODD_END > WS_EVEN_END ? (WS_ODD_END > WS_MOE_END ? WS_ODD_END : WS_MOE_END) : (WS_EVEN_END > WS_MOE_END ? WS_EVEN_END : WS_MOE_END);
#ifndef TINY
static_assert(WS_END <= (size_t)1024 * 1024 * 1024, "workspace must fit 1 GiB");
#endif

struct Prm {
    const float* in[N_IN];
    float* out;
    unsigned char* ws;
};
#define WSP(T, off) ((T*)(p.ws + (off)))

#ifdef CPU_EMU
static inline int atomic_add_int(int* a, int v) { int o = *a; *a += v; return o; }
#else
__device__ __forceinline__ int atomic_add_int(int* a, int v) { return atomicAdd(a, v); }
#endif

HD int row_b(int r) { return r / TPB; }
HD int row_t(int r) { return r % TPB; }
HD int row_modj(int r) { return row_t(r) < CTX ? NB : row_b(r); }
HD const float* mod_ptr(const Prm& p, int layer, int j, int which) { return WSP(const float, WS_MODS) + ((size_t)(layer * (NB + 1) + j) * 6 + which) * DM; }

HD void st_wt_item(const float* src, int K, int N, bf16_t* dst, size_t idx) {
    const int n = (int)(idx / K), k = (int)(idx % K);
    dst[idx] = f2bf(src[(size_t)k * N + n]);
}
constexpr size_t N_WT_ABIN = (size_t)NEVEN * ABIN * DM, N_WT_ABOUT = (size_t)NEVEN * DM * DM, N_WT_SIN = (size_t)NODD * SSD_NP * DM, N_WT_SOUT = (size_t)NODD * DM * SSD_DI;
HD void st_prolog_w(const Prm& p, size_t idx) {
    if (idx < N_WT_ABIN) { const int l = (int)(idx / ((size_t)ABIN * DM)); const size_t j = idx % ((size_t)ABIN * DM);
        st_wt_item(p.in[I_ABWIN] + (size_t)l * DM * ABIN, DM, ABIN, WSP(bf16_t, WS_WABIN) + (size_t)l * ABIN * DM, j); return; }
    idx -= N_WT_ABIN;
    if (idx < N_WT_ABOUT) { const int l = (int)(idx / ((size_t)DM * DM)); const size_t j = idx % ((size_t)DM * DM);
        st_wt_item(p.in[I_ABWOUT] + (size_t)l * DM * DM, DM, DM, WSP(bf16_t, WS_WABOUT) + (size_t)l * DM * DM, j); return; }
    idx -= N_WT_ABOUT;
    if (idx < N_WT_SIN) { const int l = (int)(idx / ((size_t)SSD_NP * DM)); const size_t j = idx % ((size_t)SSD_NP * DM);
        const int n = (int)(j / DM), k = (int)(j % DM);
        WSP(bf16_t, WS_WSIN)[(size_t)l * SSD_NP * DM + j] = n < SSD_IN ? f2bf(p.in[I_SSDWIN][(size_t)l * DM * SSD_IN + (size_t)k * SSD_IN + n]) : (bf16_t)0; return; }
    idx -= N_WT_SIN;
    { const int l = (int)(idx / ((size_t)DM * SSD_DI)); const size_t j = idx % ((size_t)DM * SSD_DI);
        st_wt_item(p.in[I_SSDWOUT] + (size_t)l * SSD_DI * DM, SSD_DI, DM, WSP(bf16_t, WS_WSOUT) + (size_t)l * DM * SSD_DI, j); }
}
constexpr size_t N_PROLOG_W = N_WT_ABIN + N_WT_ABOUT + N_WT_SIN + N_WT_SOUT;

constexpr size_t N_W1 = (size_t)MOE_E * 2 * MOE_HID * DM, N_W2 = (size_t)MOE_E * DM * MOE_HID;
HD void st_moe_w(const Prm& p, int layer, size_t idx) {
    if (idx < N_W1) {
        const int e = (int)(idx / ((size_t)2 * MOE_HID * DM)); const size_t j = idx % ((size_t)2 * MOE_HID * DM);
        const int row = (int)(j / DM), k = (int)(j % DM), pn = row / (2 * MOE_HB), rr = row % (2 * MOE_HB), isup = rr / MOE_HB, col = pn * MOE_HB + rr % MOE_HB;
        const float* src = (isup ? p.in[I_MWUP] : p.in[I_MWGATE]) + ((size_t)(layer * MOE_E + e) * DM + k) * MOE_HID + col;
        WSP(bf16_t, WS_W1)[idx] = f2bf(*src); return; }
    idx -= N_W1;
    { const int e = (int)(idx / ((size_t)DM * MOE_HID)); const size_t j = idx % ((size_t)DM * MOE_HID);
      const int n = (int)(j / MOE_HID), k = (int)(j % MOE_HID);
      WSP(bf16_t, WS_W2)[idx] = f2bf(p.in[I_MWDOWN][((size_t)(layer * MOE_E + e) * MOE_HID + k) * DM + n]); }
}
constexpr size_t N_MOE_W = N_W1 + N_W2;

HD void st_mods(const Prm& p, size_t idx) {
    const int l = (int)(idx / (6 * DM)), n = (int)(idx % (6 * DM));
    float acc[NB + 1];
#pragma unroll
    for (int j = 0; j <= NB; ++j) acc[j] = 0.f;
    const float* w = p.in[I_ADAW] + (size_t)l * DM * 6 * DM + n;
    for (int k = 0; k < DM; ++k) { const float wv = w[(size_t)k * 6 * DM];
#pragma unroll
        for (int j = 0; j < NB; ++j) acc[j] += siluf(p.in[I_C][j * DM + k]) * wv;
        acc[NB] += siluf(p.in[I_CCTX][k]) * wv; }
    const float bv = p.in[I_ADAB][(size_t)l * 6 * DM + n];
#pragma unroll
    for (int j = 0; j <= NB; ++j) WSP(float, WS_MODS)[((size_t)(l * (NB + 1) + j)) * 6 * DM + n] = acc[j] + bv;
}
constexpr size_t N_MODS = (size_t)DEPTH * 6 * DM;

HD void st_xinit(const Prm& p, size_t idx) {
    const int r = (int)(idx / DM), d = (int)(idx % DM), b = row_b(r), t = row_t(r);
    WSP(float, WS_X)[idx] = t < CTX ? p.in[I_CTX][((size_t)b * CTX + t) * DM + d] : p.in[I_X][((size_t)b * SEQ + (t - CTX)) * DM + d];
}
HD float lam_init_of(int i) { return 0.8f - 0.6f * expf(-0.3f * (float)(2 * i)); }
HD void st_misc(const Prm& p, size_t idx) {
    if (idx < (size_t)DEPTH * MOE_E) { WSP(int, WS_CNT)[idx] = 0; return; }
    if (idx >= (size_t)DEPTH * MOE_E + NEVEN + (size_t)GRID_W * (QKD / 4)) { const size_t q = idx - ((size_t)DEPTH * MOE_E + NEVEN + (size_t)GRID_W * (QKD / 4));
        const int l = (int)(q / ((size_t)WET_ROWS * DM)), e = (int)((q / DM) % WET_ROWS), k = (int)(q % DM);
        const float v = e < MOE_E ? p.in[I_MWE][((size_t)l * DM + k) * MOE_E + e] : (e < MOE_E + MOE_G ? p.in[I_MWG][((size_t)l * DM + k) * MOE_G + (e - MOE_E)] : 0.f);
        const bf16_t hi = f2bf(v), lo = f2bf(v - bf2f(hi));
        WSP(bf16_t, WS_WET)[((size_t)(l * 2 + 0) * WET_ROWS + e) * DM + k] = hi; WSP(bf16_t, WS_WET)[((size_t)(l * 2 + 1) * WET_ROWS + e) * DM + k] = lo; return; }
    if (idx >= (size_t)DEPTH * MOE_E + NEVEN) { const int q = (int)(idx - (size_t)DEPTH * MOE_E - NEVEN), pv = q / (QKD / 4), fi = q % (QKD / 4);
        const float ang = (float)pv * powf(10000.f, -(float)(2 * fi) / (float)(QKD / 2));
        WSP(float, WS_ROPE)[2 * q] = cosf(ang); WSP(float, WS_ROPE)[2 * q + 1] = sinf(ang); return; }
    const int i = (int)(idx - (size_t)DEPTH * MOE_E);
    float s1 = 0.f, s2 = 0.f;
    for (int d = 0; d < QKD; ++d) { s1 += p.in[I_LQ1][i * QKD + d] * p.in[I_LK1][i * QKD + d]; s2 += p.in[I_LQ2][i * QKD + d] * p.in[I_LK2][i * QKD + d]; }
    WSP(float, WS_LAM)[i] = expf(s1) - expf(s2) + lam_init_of(i);
}
constexpr size_t N_MISC = (size_t)DEPTH * MOE_E + NEVEN + (size_t)GRID_W * (QKD / 4) + (size_t)DEPTH * WET_ROWS * DM;

HD void st_norm1(const Prm& p, int layer, size_t r) {
    const float* x = WSP(const float, WS_X) + r * DM;
    float ss = 0.f; for (int d = 0; d < DM; ++d) ss += x[d] * x[d];
    const float rs = 1.f / sqrtf(ss / DM + 1e-6f);
    const int j = row_modj((int)r); const float* sh = mod_ptr(p, layer, j, 0); const float* sc = mod_ptr(p, layer, j, 1); const float* g = p.in[I_N1G] + (size_t)layer * DM;
    bf16_t* h = WSP(bf16_t, WS_H) + r * DM;
    for (int d = 0; d < DM; ++d) h[d] = f2bf(x[d] * rs * g[d] * (1.f + sc[d]) + sh[d]);
}

struct U4 { unsigned x, y, z, w; };
HD void unpack8(const bf16_t* p, float (&f)[8]) {
    U4 u; memcpy(&u, p, 16);
    unsigned w[4] = {u.x, u.y, u.z, u.w};
#pragma unroll
    for (int i = 0; i < 4; ++i) { unsigned lo = w[i] << 16, hi = w[i] & 0xffff0000u; memcpy(&f[2 * i], &lo, 4); memcpy(&f[2 * i + 1], &hi, 4); }
}
HD void gemm_blk(const bf16_t* A, size_t lda, const bf16_t* Bt, size_t ldb, int K, float (&acc)[4][4]) {
#pragma unroll
    for (int i = 0; i < 4; ++i)
#pragma unroll
        for (int j = 0; j < 4; ++j) acc[i][j] = 0.f;
    for (int k = 0; k < K; k += 8) {
        float a[4][8], b[4][8];
#pragma unroll
        for (int i = 0; i < 4; ++i) unpack8(A + i * lda + k, a[i]);
#pragma unroll
        for (int j = 0; j < 4; ++j) unpack8(Bt + j * ldb + k, b[j]);
#pragma unroll
        for (int i = 0; i < 4; ++i)
#pragma unroll
            for (int j = 0; j < 4; ++j)
#pragma unroll
                for (int q = 0; q < 8; ++q) acc[i][j] += a[i][q] * b[j][q];
    }
}
HD void st_gemm_bf16(const bf16_t* A, int K, const bf16_t* Bt, int N, bf16_t* C, size_t idx) {
    const int nb = N / 4; const int r0 = (int)(idx / nb) * 4, n0 = (int)(idx % nb) * 4;
    float acc[4][4]; gemm_blk(A + (size_t)r0 * K, K, Bt + (size_t)n0 * K, K, K, acc);
#pragma unroll
    for (int i = 0; i < 4; ++i)
#pragma unroll
        for (int j = 0; j < 4; ++j) C[(size_t)(r0 + i) * N + n0 + j] = f2bf(acc[i][j]);
}
HD void st_gemm_res(const Prm& p, int layer, const bf16_t* A, int K, const bf16_t* Bt, size_t idx) {
    const int nb = DM / 4; const int r0 = (int)(idx / nb) * 4, n0 = (int)(idx % nb) * 4;
    float acc[4][4]; gemm_blk(A + (size_t)r0 * K, K, Bt + (size_t)n0 * K, K, K, acc);
#pragma unroll
    for (int i = 0; i < 4; ++i) { const float* gate = mod_ptr(p, layer, row_modj(r0 + i), 2);
#pragma unroll
        for (int j = 0; j < 4; ++j) WSP(float, WS_X)[(size_t)(r0 + i) * DM + n0 + j] += gate[n0 + j] * acc[i][j]; }
}

constexpr int ROPE_PAIRS = 2 * NDH * 2 * 2 * (QKD / 4);
HD void st_rope(const Prm& p, size_t idx) {
    const int r = (int)(idx / ROPE_PAIRS); int q = (int)(idx % ROPE_PAIRS);
    const int t = row_t(r); if (t < CTX) return;
    const int pos = t - CTX;
    const int i = q % (QKD / 4); q /= (QKD / 4); const int axis = q % 2; q /= 2; const int c = q % 2; q /= 2; const int h = q % NDH; q /= NDH; const int which = q;
    const int col = which * DW + h * VD + c * QKD + axis * (QKD / 2) + i;
    const float posv = axis == 0 ? (float)(pos / GRID_W) : (float)(pos % GRID_W);
    const float inv = powf(10000.f, -(float)(2 * i) / (float)(QKD / 2));
    const float ang = posv * inv, cs = cosf(ang), sn = sinf(ang);
    bf16_t* base = WSP(bf16_t, WS_QKVC) + (size_t)r * ABIN + col;
    const float x1 = bf2f(base[0]), x2 = bf2f(base[QKD / 4]);
    base[0] = f2bf(x1 * cs - x2 * sn); base[QKD / 4] = f2bf(x2 * cs + x1 * sn);
}
HD void st_bconv(const Prm& p, int i_even, size_t idx) {
    const int r = (int)(idx / CW), ch = (int)(idx % CW), t = row_t(r);
    const bool first = (t == 0) || (t == CTX), last = (t == CTX - 1) || (t == TPB - 1);
    const bf16_t* q = WSP(const bf16_t, WS_QKVC) + (size_t)r * ABIN;
    const float* w = p.in[I_BCONV] + (size_t)i_even * 3 * CW;
    float u0 = 0.f, u2 = 0.f;
    const float u1 = bf2f(q[3 * DW + CW + ch]) * bf2f(q[3 * DW + 2 * CW + ch]);
    if (!first) u0 = bf2f(q[-(long)ABIN + 3 * DW + CW + ch]) * bf2f(q[-(long)ABIN + 3 * DW + 2 * CW + ch]);
    if (!last)  u2 = bf2f(q[(long)ABIN + 3 * DW + CW + ch]) * bf2f(q[(long)ABIN + 3 * DW + 2 * CW + ch]);
    const float cv = w[ch] * u0 + w[CW + ch] * u1 + w[2 * CW + ch] * u2;
    WSP(bf16_t, WS_CAT)[(size_t)r * DM + DW + ch] = f2bf(bf2f(q[3 * DW + ch]) * cv);
}
HD void st_attn(const Prm& p, size_t idx) {
    const int vh = (int)(idx % 2); const int qh = (int)((idx / 2) % (2 * NDH)); const int r = (int)(idx / (4 * NDH));
    const int h = qh / 2, c = qh % 2, b = row_b(r), t = row_t(r);
    const int k0 = b * TPB, nk = t < CTX ? CTX : TPB;
    const bf16_t* Q = WSP(const bf16_t, WS_QKVC);
    float q[QKD], o[QKD];
#pragma unroll
    for (int d = 0; d < QKD; ++d) { q[d] = bf2f(Q[(size_t)r * ABIN + h * VD + c * QKD + d]); o[d] = 0.f; }
    float m = -1e30f, l = 0.f; const float scale = 1.f / sqrtf((float)QKD);
    for (int kk = 0; kk < nk; ++kk) {
        const bf16_t* kr = Q + (size_t)(k0 + kk) * ABIN + DW + h * VD + c * QKD;
        float s = 0.f;
#pragma unroll
        for (int d = 0; d < QKD; ++d) s += q[d] * bf2f(kr[d]);
        s *= scale;
        const float mn = s > m ? s : m, al = expf(m - mn), pe = expf(s - mn);
        l = l * al + pe; m = mn;
        const bf16_t* vr = Q + (size_t)(k0 + kk) * ABIN + 2 * DW + h * VD + vh * QKD;
#pragma unroll
        for (int d = 0; d < QKD; ++d) o[d] = o[d] * al + pe * bf2f(vr[d]);
    }
    float* O = WSP(float, WS_O12) + ((size_t)r * 2 * NDH + qh) * VD + vh * QKD;
    const float il = 1.f / l;
#pragma unroll
    for (int d = 0; d < QKD; ++d) O[d] = o[d] * il;
}
HD void st_combine(const Prm& p, int i_even, size_t idx) {
    const int r = (int)(idx / NDH), h = (int)(idx % NDH);
    const float lam = WSP(const float, WS_LAM)[i_even], li = lam_init_of(i_even);
    const float* o1 = WSP(const float, WS_O12) + ((size_t)r * 2 * NDH + 2 * h) * VD; const float* o2 = o1 + VD;
    float ss = 0.f; for (int d = 0; d < VD; ++d) { const float v = o1[d] - lam * o2[d]; ss += v * v; }
    const float rs = 1.f / sqrtf(ss / VD + 1e-6f);
    const float* g = p.in[I_SUBLN] + (size_t)i_even * VD;
    for (int d = 0; d < VD; ++d) WSP(bf16_t, WS_CAT)[(size_t)r * DM + h * VD + d] = f2bf((o1[d] - lam * o2[d]) * rs * g[d] * (1.f - li));
}

HD void st_ssdconv(const Prm& p, int i_odd, size_t idx) {
    const int per = SSD_CC + 2 * SSD_H; const int r = (int)(idx / per), ch = (int)(idx % per), t = row_t(r);
    const bf16_t* z = WSP(const bf16_t, WS_ZXD) + (size_t)r * SSD_NP;
    if (ch < SSD_CC) {
        const bool first = (t == 0) || (t == CTX), last = (t == CTX - 1) || (t == TPB - 1);
        const float* w = p.in[I_SSDCW] + (size_t)i_odd * 3 * SSD_CC;
        float v = w[SSD_CC + ch] * bf2f(z[SSD_DI + ch]) + p.in[I_SSDCB][(size_t)i_odd * SSD_CC + ch];
        if (!first) v += w[ch] * bf2f(z[-(long)SSD_NP + SSD_DI + ch]);
        if (!last) v += w[2 * SSD_CC + ch] * bf2f(z[(long)SSD_NP + SSD_DI + ch]);
        WSP(bf16_t, WS_XBC)[(size_t)r * SSD_CC + ch] = f2bf(siluf(v));
    } else {
        const int j = ch - SSD_CC;
        WSP(float, WS_DT)[(size_t)r * 2 * SSD_H + j] = softplusf(bf2f(z[SSD_DI + SSD_CC + j]) + p.in[I_SSDDTB][(size_t)i_odd * 2 * SSD_H + j]);
    }
}
HD void st_ssd(const Prm& p, int i_odd, size_t idx) {
    const int pp = (int)(idx % SSD_P); const int h = (int)((idx / SSD_P) % SSD_H); const int dir = (int)((idx / (SSD_P * SSD_H)) % 2); const int b = (int)(idx / (SSD_P * SSD_H * 2));
    const int g = h / SSD_E;
    const float A = -expf(p.in[I_SSDALOG][(size_t)i_odd * 2 * SSD_H + dir * SSD_H + h]);
    float st[SSD_N];
#pragma unroll
    for (int n = 0; n < SSD_N; ++n) st[n] = 0.f;
    const bf16_t* XBC = WSP(const bf16_t, WS_XBC); const float* DT = WSP(const float, WS_DT);
    bf16_t* Y = WSP(bf16_t, WS_YS) + (size_t)dir * R * SSD_DI;
    for (int s = 0; s < TPB; ++s) {
        int t;
        if (dir == 0) t = s; else t = s < CTX ? (CTX - 1 - s) : (TPB - 1 - (s - CTX));
        const size_t r = (size_t)b * TPB + t;
        const float dt = DT[r * 2 * SSD_H + dir * SSD_H + h];
        const float xdt = bf2f(XBC[r * SSD_CC + h * SSD_P + pp]) * dt, dec = expf(dt * A);
        const bf16_t* Bm = XBC + r * SSD_CC + SSD_DI + g * SSD_N; const bf16_t* Cm = Bm + SSD_G * SSD_N;
        float y = 0.f;
#pragma unroll
        for (int n = 0; n < SSD_N; ++n) { st[n] = st[n] * dec + bf2f(Bm[n]) * xdt; y += bf2f(Cm[n]) * st[n]; }
        Y[r * SSD_DI + h * SSD_P + pp] = f2bf(y);
    }
}
HD void st_gnorm(const Prm& p, int i_odd, size_t idx) {
    const int r = (int)(idx / SSD_G), g = (int)(idx % SSD_G); constexpr int GW = SSD_DI / SSD_G;
    const bf16_t* yf = WSP(const bf16_t, WS_YS) + (size_t)r * SSD_DI + g * GW; const bf16_t* yb = yf + (size_t)R * SSD_DI;
    const bf16_t* xs = WSP(const bf16_t, WS_XBC) + (size_t)r * SSD_CC + g * GW; const bf16_t* z = WSP(const bf16_t, WS_ZXD) + (size_t)r * SSD_NP + g * GW;
    const float* Dk = p.in[I_SSDD] + (size_t)i_odd * SSD_H; const float* ng = p.in[I_SSDNG] + (size_t)i_odd * SSD_DI + g * GW;
    float ss = 0.f;
    for (int d = 0; d < GW; ++d) { const float v = (bf2f(yf[d]) + bf2f(yb[d]) + bf2f(xs[d]) * Dk[(g * GW + d) / SSD_P]) * siluf(bf2f(z[d])); ss += v * v; }
    const float rs = 1.f / sqrtf(ss / GW + 1e-6f);
    for (int d = 0; d < GW; ++d) { const float v = (bf2f(yf[d]) + bf2f(yb[d]) + bf2f(xs[d]) * Dk[(g * GW + d) / SSD_P]) * siluf(bf2f(z[d]));
        WSP(bf16_t, WS_YN)[(size_t)r * SSD_DI + g * GW + d] = f2bf(v * rs * ng[d]); }
}

HD void st_norm2_route(const Prm& p, int layer, size_t r) {
    const float* x = WSP(const float, WS_X) + r * DM;
    float ss = 0.f; for (int d = 0; d < DM; ++d) ss += x[d] * x[d];
    const float rs = 1.f / sqrtf(ss / DM + 1e-6f);
    const int j = row_modj((int)r); const float* sh = mod_ptr(p, layer, j, 3); const float* sc = mod_ptr(p, layer, j, 4); const float* g = p.in[I_N2G] + (size_t)layer * DM;
    bf16_t* h = WSP(bf16_t, WS_H) + r * DM;
    float lg[MOE_G], le[MOE_E];
#pragma unroll
    for (int i = 0; i < MOE_G; ++i) lg[i] = p.in[I_MBG][layer * MOE_G + i];
#pragma unroll
    for (int i = 0; i < MOE_E; ++i) le[i] = p.in[I_MBE][layer * MOE_E + i];
    const float* wg = p.in[I_MWG] + (size_t)layer * DM * MOE_G; const float* we = p.in[I_MWE] + (size_t)layer * DM * MOE_E;
    for (int d = 0; d < DM; ++d) { const float v = x[d] * rs * g[d] * (1.f + sc[d]) + sh[d]; h[d] = f2bf(v);
#pragma unroll
        for (int i = 0; i < MOE_G; ++i) lg[i] += v * wg[(size_t)d * MOE_G + i];
#pragma unroll
        for (int i = 0; i < MOE_E; ++i) le[i] += v * we[(size_t)d * MOE_E + i]; }
    int gi = 0; float gm = lg[0];
#pragma unroll
    for (int i = 1; i < MOE_G; ++i) if (lg[i] > gm) { gm = lg[i]; gi = i; }
    float gs = 0.f;
#pragma unroll
    for (int i = 0; i < MOE_G; ++i) gs += expf(lg[i] - gm);
    const float g_w = 1.f / gs;
    float el[MOE_EPG];
#pragma unroll
    for (int i = 0; i < MOE_EPG; ++i) { float v = 0.f;
#pragma unroll
        for (int gg = 0; gg < MOE_G; ++gg) v = (gg == gi) ? le[gg * MOE_EPG + i] : v;
        el[i] = v; }
    int i0 = 0; float m0 = el[0];
#pragma unroll
    for (int i = 1; i < MOE_EPG; ++i) if (el[i] > m0) { m0 = el[i]; i0 = i; }
    int i1 = -1; float m1 = -3.4e38f;
#pragma unroll
    for (int i = 0; i < MOE_EPG; ++i) if (i != i0 && el[i] > m1) { m1 = el[i]; i1 = i; }
    const float p1 = expf(m1 - m0);
    const float w0 = g_w / (1.f + p1), w1 = g_w * p1 / (1.f + p1);
    const int e0 = gi * MOE_EPG + i0, e1 = gi * MOE_EPG + i1;
    int* cnt = WSP(int, WS_CNT) + layer * MOE_E;
    const int r0 = atomic_add_int(&cnt[e0], 1), r1 = atomic_add_int(&cnt[e1], 1);
    int* ro = WSP(int, WS_ROUTE) + r * 8;
    ro[0] = e0; ro[1] = e1; ro[2] = r0; ro[3] = r1; memcpy(&ro[4], &w0, 4); memcpy(&ro[5], &w1, 4);
}
HD int moe_off(const int* cnt, int e) { int o = 0; for (int i = 0; i < e; ++i) o += (cnt[i] + MOE_MT - 1) / MOE_MT * MOE_MT; return o; }
HD int moe_slot_expert(const int* cnt, int slot, int& off) { int o = 0; for (int i = 0; i < MOE_E; ++i) { const int pc = (cnt[i] + MOE_MT - 1) / MOE_MT * MOE_MT; if (slot < o + pc) { off = o; return i; } o += pc; } off = o; return -1; }
HD void st_gather(const Prm& p, int layer, size_t idx) {
    const size_t r = idx / 2; const int j = (int)(idx % 2);
    int* ro = WSP(int, WS_ROUTE) + r * 8; const int* cnt = WSP(const int, WS_CNT) + layer * MOE_E;
    const int slot = moe_off(cnt, ro[j]) + ro[2 + j];
    ro[6 + j] = slot;
    const bf16_t* h = WSP(const bf16_t, WS_H) + r * DM; bf16_t* xb = WSP(bf16_t, WS_XB) + (size_t)slot * DM;
    for (int d = 0; d < DM; ++d) xb[d] = h[d];
}
HD void st_moe1(const Prm& p, int layer, size_t idx) {
    const int jb = (int)(idx % (MOE_HID / 4)) * 4; const int slot = (int)(idx / (MOE_HID / 4));
    const int* cnt = WSP(const int, WS_CNT) + layer * MOE_E; int off; const int e = moe_slot_expert(cnt, slot, off);
    if (e < 0 || slot - off >= cnt[e]) return;
    const bf16_t* xb = WSP(const bf16_t, WS_XB) + (size_t)slot * DM; const bf16_t* w1 = WSP(const bf16_t, WS_W1) + (size_t)e * 2 * MOE_HID * DM;
    for (int j = jb; j < jb + 4; ++j) {
        const int pn = j / MOE_HB, jj = j % MOE_HB; const bf16_t* wgr = w1 + (size_t)(pn * 2 * MOE_HB + jj) * DM; const bf16_t* wur = wgr + (size_t)MOE_HB * DM;
        float ga = 0.f, up = 0.f;
        for (int k = 0; k < DM; ++k) { const float xv = bf2f(xb[k]); ga += xv * bf2f(wgr[k]); up += xv * bf2f(wur[k]); }
        WSP(bf16_t, WS_ACT)[(size_t)slot * MOE_HID + j] = f2bf(siluf(ga) * up);
    }
}
HD void st_moe2(const Prm& p, int layer, size_t idx) {
    const int nb = (int)(idx % (DM / 4)) * 4; const int slot = (int)(idx / (DM / 4));
    const int* cnt = WSP(const int, WS_CNT) + layer * MOE_E; int off; const int e = moe_slot_expert(cnt, slot, off);
    if (e < 0 || slot - off >= cnt[e]) return;
    const bf16_t* a = WSP(const bf16_t, WS_ACT) + (size_t)slot * MOE_HID; const bf16_t* w2 = WSP(const bf16_t, WS_W2) + (size_t)e * DM * MOE_HID;
    for (int n = nb; n < nb + 4; ++n) { float acc = 0.f; const bf16_t* wr = w2 + (size_t)n * MOE_HID;
        for (int k = 0; k < MOE_HID; ++k) acc += bf2f(a[k]) * bf2f(wr[k]);
        WSP(bf16_t, WS_YB)[(size_t)slot * DM + n] = f2bf(acc); }
}
HD void st_moe_comb(const Prm& p, int layer, size_t idx) {
    const size_t r = idx / DM; const int d = (int)(idx % DM);
    const int* ro = WSP(const int, WS_ROUTE) + r * 8; float w0, w1; memcpy(&w0, &ro[4], 4); memcpy(&w1, &ro[5], 4);
    const float* gate = mod_ptr(p, layer, row_modj((int)r), 5);
    const bf16_t* yb = WSP(const bf16_t, WS_YB);
    WSP(float, WS_X)[idx] += gate[d] * (w0 * bf2f(yb[(size_t)ro[6] * DM + d]) + w1 * bf2f(yb[(size_t)ro[7] * DM + d]));
}
HD void st_final(const Prm& p, size_t idx) {
    const int b = (int)(idx / SEQ), t = (int)(idx % SEQ); const size_t r = (size_t)b * TPB + CTX + t;
    const float* x = WSP(const float, WS_X) + r * DM;
    float ss = 0.f; for (int d = 0; d < DM; ++d) ss += x[d] * x[d];
    const float rs = 1.f / sqrtf(ss / DM + 1e-6f);
    for (int d = 0; d < DM; ++d) p.out[idx * DM + d] = x[d] * rs * p.in[I_FNG][d];
}

enum { ST_PROLOG_W, ST_MODS, ST_XINIT, ST_MISC, ST_MOE_W, ST_NORM1, ST_G1E, ST_ROPE, ST_BCONV, ST_ATTN, ST_COMBINE, ST_G2E,
       ST_G1O, ST_SSDCONV, ST_SSD, ST_GNORM, ST_G2O, ST_N2RT, ST_GATHER, ST_MOE1, ST_MOE2, ST_MOECOMB, ST_FINAL, N_ST };
HD size_t stage_items(int st) {
    switch (st) {
    case ST_PROLOG_W: return N_PROLOG_W; case ST_MODS: return N_MODS; case ST_XINIT: return (size_t)R * DM; case ST_MISC: return N_MISC; case ST_MOE_W: return N_MOE_W;
    case ST_NORM1: return R; case ST_G1E: return (size_t)(R / 4) * (ABIN / 4); case ST_ROPE: return (size_t)R * ROPE_PAIRS; case ST_BCONV: return (size_t)R * CW;
    case ST_ATTN: return (size_t)R * 4 * NDH; case ST_COMBINE: return (size_t)R * NDH; case ST_G2E: return (size_t)(R / 4) * (DM / 4);
    case ST_G1O: return (size_t)(R / 4) * (SSD_NP / 4); case ST_SSDCONV: return (size_t)R * (SSD_CC + 2 * SSD_H); case ST_SSD: return (size_t)NB * 2 * SSD_H * SSD_P;
    case ST_GNORM: return (size_t)R * SSD_G; case ST_G2O: return (size_t)(R / 4) * (DM / 4); case ST_N2RT: return R; case ST_GATHER: return (size_t)R * 2;
    case ST_MOE1: return (size_t)NSLOT * (MOE_HID / 4); case ST_MOE2: return (size_t)NSLOT * (DM / 4); case ST_MOECOMB: return (size_t)R * DM; case ST_FINAL: return (size_t)NB * SEQ;
    } return 0;
}
template <int ST> HD void stage_item(const Prm& p, int layer, size_t idx) {
    const int ih = layer / 2;
    if constexpr (ST == ST_PROLOG_W) st_prolog_w(p, idx);
    else if constexpr (ST == ST_MODS) st_mods(p, idx);
    else if constexpr (ST == ST_XINIT) st_xinit(p, idx);
    else if constexpr (ST == ST_MISC) st_misc(p, idx);
    else if constexpr (ST == ST_MOE_W) st_moe_w(p, layer, idx);
    else if constexpr (ST == ST_NORM1) st_norm1(p, layer, idx);
    else if constexpr (ST == ST_G1E) st_gemm_bf16(WSP(const bf16_t, WS_H), DM, WSP(const bf16_t, WS_WABIN) + (size_t)ih * ABIN * DM, ABIN, WSP(bf16_t, WS_QKVC), idx);
    else if constexpr (ST == ST_ROPE) st_rope(p, idx);
    else if constexpr (ST == ST_BCONV) st_bconv(p, ih, idx);
    else if constexpr (ST == ST_ATTN) st_attn(p, idx);
    else if constexpr (ST == ST_COMBINE) st_combine(p, ih, idx);
    else if constexpr (ST == ST_G2E) st_gemm_res(p, layer, WSP(const bf16_t, WS_CAT), DM, WSP(const bf16_t, WS_WABOUT) + (size_t)ih * DM * DM, idx);
    else if constexpr (ST == ST_G1O) st_gemm_bf16(WSP(const bf16_t, WS_H), DM, WSP(const bf16_t, WS_WSIN) + (size_t)ih * SSD_NP * DM, SSD_NP, WSP(bf16_t, WS_ZXD), idx);
    else if constexpr (ST == ST_SSDCONV) st_ssdconv(p, ih, idx);
    else if constexpr (ST == ST_SSD) st_ssd(p, ih, idx);
    else if constexpr (ST == ST_GNORM) st_gnorm(p, ih, idx);
    else if constexpr (ST == ST_G2O) st_gemm_res(p, layer, WSP(const bf16_t, WS_YN), SSD_DI, WSP(const bf16_t, WS_WSOUT) + (size_t)ih * DM * SSD_DI, idx);
    else if constexpr (ST == ST_N2RT) st_norm2_route(p, layer, idx);
    else if constexpr (ST == ST_GATHER) st_gather(p, layer, idx);
    else if constexpr (ST == ST_MOE1) st_moe1(p, layer, idx);
    else if constexpr (ST == ST_MOE2) st_moe2(p, layer, idx);
    else if constexpr (ST == ST_MOECOMB) st_moe_comb(p, layer, idx);
    else if constexpr (ST == ST_FINAL) st_final(p, idx);
}

template <int layer, class Runner> HD void layer_program(Runner& run) {
    run.template go<ST_MOE_W>(layer); run.template go<ST_NORM1>(layer); run.sync();
    if constexpr (layer % 2 == 0) {
        run.template go<ST_G1E>(layer); run.sync();
        run.template go<ST_ROPE>(layer); run.template go<ST_BCONV>(layer); run.sync();
        run.template go<ST_ATTN>(layer); run.sync();
        run.template go<ST_COMBINE>(layer); run.sync();
        run.template go<ST_G2E>(layer); run.sync();
    } else {
        run.template go<ST_G1O>(layer); run.sync();
        run.template go<ST_SSDCONV>(layer); run.sync();
        run.template go<ST_SSD>(layer); run.sync();
        run.template go<ST_GNORM>(layer); run.sync();
        run.template go<ST_G2O>(layer); run.sync();
    }
    run.template go<ST_N2RT>(layer); run.sync();
    run.template go<ST_GATHER>(layer); run.sync();
    run.template go<ST_MOE1>(layer); run.sync();
    run.template go<ST_MOE2>(layer); run.sync();
    run.template go<ST_MOECOMB>(layer); run.sync();
}
template <class Runner> HD void forward_program(Runner& run) {
    run.template go<ST_PROLOG_W>(0); run.template go<ST_MODS>(0); run.template go<ST_XINIT>(0); run.template go<ST_MISC>(0); run.sync();
    layer_program<0>(run); layer_program<1>(run); layer_program<2>(run); layer_program<3>(run);
    static_assert(DEPTH == 4, "layers are unrolled by hand");
    run.template go<ST_FINAL>(0);
}

#ifndef CPU_EMU
#define XB_TMO      128
#define XB_XCNT(j)  (256  + 64 * (j))
#define XB_XSUB(j)  (1280 + 64 * (j))
#define XB_XGEN(j)  (2304 + 64 * (j))
#define XB_TOP      3328
#define XB_TOPGEN   3392
#define XCD_BAR_WORDS 3456
#define XB_SPIN_CAP (1u << 22)
#define LAS __attribute__((address_space(3)))

__device__ __forceinline__ unsigned xb_ld(unsigned* p)              { return __hip_atomic_load(p, __ATOMIC_RELAXED, __HIP_MEMORY_SCOPE_AGENT); }
__device__ __forceinline__ unsigned xb_add(unsigned* p, unsigned v) { return __hip_atomic_fetch_add(p, v, __ATOMIC_RELAXED, __HIP_MEMORY_SCOPE_AGENT); }
__device__ __forceinline__ unsigned xb_xcc_id() { return (unsigned)__builtin_amdgcn_s_getreg((3 << 11) | 20) & 0xFu; }
#define XB_SPIN(cond, bar) do { unsigned _sp = 0; while (cond) { __builtin_amdgcn_s_sleep(1); \
    if ((++_sp & 255u) == 0u) { if (xb_ld(&(bar)[XB_TMO])) break; if (_sp > XB_SPIN_CAP) { atomicAdd(&(bar)[XB_TMO], 1u); break; } } } } while (0)

struct XcdBarrier {
    unsigned* bar; unsigned x;
    volatile LAS unsigned* st;
};
__device__ __forceinline__ XcdBarrier xcd_barrier_post(unsigned* bar, volatile LAS unsigned* st) {
    XcdBarrier b; b.bar = bar; b.x = xb_xcc_id(); b.st = st;
    if (threadIdx.x == 0) (void)xb_add(&bar[XB_XCNT(b.x)], 1u);
    return b;
}
__device__ __forceinline__ void xcd_barrier_complete(unsigned* bar, unsigned x, unsigned& nloc, unsigned& nx) {
    const unsigned G = gridDim.x * gridDim.y * gridDim.z;
    unsigned sum, cnt, mine, sp = 0u;
    for (;;) {
        sum = 0u; cnt = 0u; mine = 0u;
#pragma unroll
        for (unsigned j = 0; j < 16; ++j) { const unsigned c = xb_ld(&bar[XB_XCNT(j)]); sum += c; cnt += (c > 0u) ? 1u : 0u; mine = (j == x) ? c : mine; }
        if (sum == G) break;
        __builtin_amdgcn_s_sleep(1);
        if ((++sp & 255u) == 0u) { if (xb_ld(&bar[XB_TMO])) break; if (sp > XB_SPIN_CAP) { atomicAdd(&bar[XB_TMO], 1u); break; } }
    }
    nloc = mine > 0u ? mine : 1u; nx = cnt > 0u ? cnt : 1u;
}
__device__ __forceinline__ void xcd_barrier(const XcdBarrier& b) {
    asm volatile("s_waitcnt vmcnt(0)" ::: "memory");
    __syncthreads();
    if (threadIdx.x == 0) {
        unsigned* bar = b.bar;
        __builtin_amdgcn_s_waitcnt(0);
        unsigned nloc = b.st[0], nx = b.st[1];
        if (nloc == 0u) { xcd_barrier_complete(bar, b.x, nloc, nx); b.st[0] = nloc; b.st[1] = nx; }
        const unsigned old = xb_add(&bar[XB_XSUB(b.x)], 1u);
        const unsigned gen = old / nloc;
        if (old + 1u == (gen + 1u) * nloc) {
            __builtin_amdgcn_fence(__ATOMIC_RELEASE, "agent");
            asm volatile("s_waitcnt vmcnt(0)" ::: "memory");
            const unsigned og = xb_add(&bar[XB_TOP], 1u);
            const unsigned tg = og / nx;
            if (og + 1u == (tg + 1u) * nx) xb_add(&bar[XB_TOPGEN], 1u);
            else XB_SPIN(xb_ld(&bar[XB_TOPGEN]) == tg, bar);
            __builtin_amdgcn_fence(__ATOMIC_ACQUIRE, "agent");
            xb_add(&bar[XB_XGEN(b.x)], 1u);
            asm volatile("s_waitcnt vmcnt(0)" ::: "memory");
        } else {
            XB_SPIN(xb_ld(&bar[XB_XGEN(b.x)]) == gen, bar);
            __builtin_amdgcn_fence(__ATOMIC_ACQUIRE, "agent");
            asm volatile("s_waitcnt vmcnt(0)" ::: "memory");
        }
    }
    __syncthreads();
}

namespace pg8 {
#define PG8_LAS __attribute__((address_space(3)))
typedef unsigned short bf16_t;
typedef short bf16x8 __attribute__((ext_vector_type(8)));
typedef float f32x4 __attribute__((ext_vector_type(4)));
typedef unsigned u32x4 __attribute__((ext_vector_type(4)));
constexpr int BM = 256, BK = 64, HALF = 128, HTB = HALF * BK * 2  , STAGE_BYTES = 8 * HTB, NXCD = 8, WGM = 8;

__host__ __device__ __forceinline__ int lds_byte(int r, int c) { const int st = (r >> 4) * 2 + (c >> 5), rr = r & 15, cc = c & 31, ob = rr * 64 + cc * 2; return st * 1024 + (ob ^ (((ob >> 9) & 1) << 5)); }
__host__ __device__ __forceinline__ void stage_rc(int b, int& R, int& C) { const int st = b / 1024, sb = b % 1024, swz = sb ^ (((sb >> 9) & 1) << 5); R = (st >> 1) * 16 + swz / 64; C = (st & 1) * 32 + (swz % 64) / 2; }
__host__ __device__ __forceinline__ int perm32(int rho) { const int n = rho >> 4, i = rho & 15; return 8 * (i >> 2) + 4 * n + (i & 3); }

struct Unit { int pm, pn, pb, ui; };
struct Gemm { const bf16_t* A; const bf16_t* Bt; int M, N, K; };

struct StaticOrder {
    int nM, nN, nwg, G, c;
    __host__ __device__ void init(int M, int N, int G_, int c_) { nM = M / BM; nN = N / BM; nwg = nM * nN; G = G_; c = c_; }
    __host__ __device__ bool next(int i, Unit& u) const {
        const long L = (long)i * G + c; if (L >= nwg) return false;
        int wgid = (int)L; { const int q = nwg / NXCD, r = nwg % NXCD, xcd = wgid % NXCD, off = wgid / NXCD; wgid = (xcd < r ? xcd * (q + 1) : r * (q + 1) + (xcd - r) * q) + off; }
        const int nig = WGM * nN, gid = wgid / nig, fm = gid * WGM, gsz = (nM - fm) < WGM ? (nM - fm) : WGM;
        u.pm = fm + ((wgid % nig) % gsz); u.pn = (wgid % nig) / gsz; u.pb = u.pn; u.ui = i; return true;
    }
    __device__ __forceinline__ void a_ready(const Unit&) const {}
    __device__ __forceinline__ void done(const Unit&) const {}
};

__device__ __forceinline__ unsigned cvt_pk_bf16(float lo, float hi) { unsigned r; asm volatile("v_cvt_pk_bf16_f32 %0, %1, %2" : "=v"(r) : "v"(lo), "v"(hi)); return r; }

struct EpiStore {
    static constexpr bool PERM = true, AFTER_DRAIN = false;
    bf16_t* O; int ldc;
    __device__ __forceinline__ void operator()(const f32x4 (&acc)[2][2][4][2], const Unit& u, int wr, int wc, int fr, int fq) const {
        const int row0 = u.pm * BM + wr * 64 + fr, col0 = u.pn * BM + wc * 32 + 8 * fq;
#pragma unroll
        for (int ai = 0; ai < 2; ++ai)
#pragma unroll
            for (int m = 0; m < 4; ++m) { bf16_t* rowp = O + (size_t)(row0 + ai * HALF + m * 16) * ldc + col0;
#pragma unroll
                for (int bj = 0; bj < 2; ++bj) { const f32x4 v0 = acc[ai][bj][m][0], v1 = acc[ai][bj][m][1];
                    u32x4 w; w.x = cvt_pk_bf16(v0[0], v0[1]); w.y = cvt_pk_bf16(v0[2], v0[3]); w.z = cvt_pk_bf16(v1[0], v1[1]); w.w = cvt_pk_bf16(v1[2], v1[3]);
                    *(u32x4*)(rowp + bj * HALF) = w; } }
    }
};
struct EpiStoreRope {
    static constexpr bool PERM = true, AFTER_DRAIN = false;
    bf16_t* O; int ldc; const float* tab; int ropeTiles;
    __device__ __forceinline__ void operator()(const f32x4 (&acc)[2][2][4][2], const Unit& u, int wr, int wc, int fr, int fq) const {
        constexpr int TPT = TPB / BM;
        const int row0 = u.pm * BM + wr * 64 + fr, col0 = u.pn * BM + wc * 32 + 8 * fq;
        const bool rope = (u.pn < ropeTiles) && (u.pm % TPT != 0);
        const float sg = fq < 2 ? -1.f : 1.f; const int axis = wc & 1;
#pragma unroll
        for (int ai = 0; ai < 2; ++ai)
#pragma unroll
            for (int m = 0; m < 4; ++m) { const int row = row0 + ai * HALF + m * 16; bf16_t* rowp = O + (size_t)row * ldc + col0;
                f32x4 cs[4];
                if (rope) { const int pos = row % TPB - CTX; const int pv = axis ? pos % GRID_W : pos / GRID_W; const float* tp = tab + ((size_t)pv * 16 + 8 * (fq & 1)) * 2;
#pragma unroll
                    for (int i = 0; i < 4; ++i) cs[i] = *(const f32x4*)(tp + 4 * i); }
#pragma unroll
                for (int bj = 0; bj < 2; ++bj) { f32x4 v0 = acc[ai][bj][m][0], v1 = acc[ai][bj][m][1];
                    if (rope) { float mine[8] = {v0[0], v0[1], v0[2], v0[3], v1[0], v1[1], v1[2], v1[3]}, o[8];
#pragma unroll
                        for (int j = 0; j < 8; ++j) { const unsigned mu = __float_as_uint(mine[j]); auto sw = __builtin_amdgcn_permlane32_swap(mu, mu, false, false);
                            const float other = __uint_as_float(fq < 2 ? sw[1] : sw[0]);
                            const float c = cs[j >> 1][(j & 1) * 2], s = cs[j >> 1][(j & 1) * 2 + 1]; o[j] = mine[j] * c + sg * other * s; }
                        v0 = (f32x4){o[0], o[1], o[2], o[3]}; v1 = (f32x4){o[4], o[5], o[6], o[7]}; }
                    u32x4 w; w.x = cvt_pk_bf16(v0[0], v0[1]); w.y = cvt_pk_bf16(v0[2], v0[3]); w.z = cvt_pk_bf16(v1[0], v1[1]); w.w = cvt_pk_bf16(v1[2], v1[3]);
                    *(u32x4*)(rowp + bj * HALF) = w; } }
    }
};
struct EpiResid {
    static constexpr bool PERM = true, AFTER_DRAIN = false;
    bf16_t* X; const float* mods_layer; int which; int ldx;
    __device__ __forceinline__ void operator()(const f32x4 (&acc)[2][2][4][2], const Unit& u, int wr, int wc, int fr, int fq) const {
        constexpr int TPT = TPB / BM;
        const int j = (u.pm % TPT == 0) ? NB : u.pm / TPT;
        const float* gate = mods_layer + ((size_t)j * 6 + which) * ldx;
        const int row0 = u.pm * BM + wr * 64 + fr, col0 = u.pn * BM + wc * 32 + 8 * fq;
        f32x4 gv[2][2];
#pragma unroll
        for (int bj = 0; bj < 2; ++bj)
#pragma unroll
            for (int n = 0; n < 2; ++n) gv[bj][n] = *(const f32x4*)(gate + col0 + bj * HALF + 4 * n);
#pragma unroll
        for (int ai = 0; ai < 2; ++ai) {
            u32x4 xin[4][2];
#pragma unroll
            for (int m = 0; m < 4; ++m)
#pragma unroll
                for (int bj = 0; bj < 2; ++bj) xin[m][bj] = *(const u32x4*)(X + (size_t)(row0 + ai * HALF + m * 16) * ldx + col0 + bj * HALF);
#pragma unroll
            for (int m = 0; m < 4; ++m) { bf16_t* rowp = X + (size_t)(row0 + ai * HALF + m * 16) * ldx + col0;
#pragma unroll
                for (int bj = 0; bj < 2; ++bj) { u32x4* q = (u32x4*)(rowp + bj * HALF); const u32x4 xo = xin[m][bj];
                    const f32x4 v0 = gv[bj][0] * acc[ai][bj][m][0], v1 = gv[bj][1] * acc[ai][bj][m][1];
                    u32x4 w;
                    w.x = cvt_pk_bf16(__uint_as_float(xo.x << 16) + v0[0], __uint_as_float(xo.x & 0xffff0000u) + v0[1]); w.y = cvt_pk_bf16(__uint_as_float(xo.y << 16) + v0[2], __uint_as_float(xo.y & 0xffff0000u) + v0[3]);
                    w.z = cvt_pk_bf16(__uint_as_float(xo.z << 16) + v1[0], __uint_as_float(xo.z & 0xffff0000u) + v1[1]); w.w = cvt_pk_bf16(__uint_as_float(xo.w << 16) + v1[2], __uint_as_float(xo.w & 0xffff0000u) + v1[3]);
                    *q = w; } } }
    }
};
struct EpiSwiGLU {
    static constexpr bool PERM = true, AFTER_DRAIN = false;
    bf16_t* O; int ldc;
    __device__ __forceinline__ void operator()(const f32x4 (&acc)[2][2][4][2], const Unit& u, int wr, int wc, int fr, int fq) const {
        const int row0 = u.pm * BM + wr * 64 + fr, col0 = u.pn * HALF + wc * 32 + 8 * fq;
#pragma unroll
        for (int ai = 0; ai < 2; ++ai)
#pragma unroll
            for (int m = 0; m < 4; ++m) { float v[8];
#pragma unroll
                for (int n = 0; n < 2; ++n)
#pragma unroll
                    for (int i = 0; i < 4; ++i) { const float g = acc[ai][0][m][n][i], up = acc[ai][1][m][n][i]; v[n * 4 + i] = g * __builtin_amdgcn_rcpf(1.f + __expf(-g)) * up; }
                u32x4 w; w.x = cvt_pk_bf16(v[0], v[1]); w.y = cvt_pk_bf16(v[2], v[3]); w.z = cvt_pk_bf16(v[4], v[5]); w.w = cvt_pk_bf16(v[6], v[7]);
                *(u32x4*)(O + (size_t)(row0 + ai * HALF + m * 16) * ldc + col0) = w; }
    }
};
struct LatentOrder {
    int G, c, nN;
    __device__ __forceinline__ bool next(int i, Unit& u) const {
        constexpr int TPT = TPB / BM, NLT = NB * (TPT - 1);
        const long L = (long)i * G + c; if (L >= (long)NLT * nN) return false;
        const int mtl = (int)(L / nN); u.pm = (mtl / (TPT - 1)) * TPT + 1 + mtl % (TPT - 1); u.pn = (int)(L % nN); u.pb = u.pn; u.ui = i; return true;
    }
    __device__ __forceinline__ void a_ready(const Unit&) const {}
    __device__ __forceinline__ void done(const Unit&) const {}
};
struct MoeOrder {
    const PG8_LAS int* pref;
    int G, c, ntn;
    __device__ __forceinline__ bool next(int i, Unit& u) const {
        const long L = (long)i * G + c; const int mt = (int)(L / ntn), pn = (int)(L % ntn);
        if (mt >= pref[MOE_E]) return false;
        int e = 0;
#pragma unroll
        for (int q = 1; q < MOE_E; ++q) e = (mt >= pref[q]) ? q : e;
        u.pm = mt; u.pn = pn; u.pb = e * ntn + pn; u.ui = i; return true;
    }
    __device__ __forceinline__ void a_ready(const Unit&) const {}
    __device__ __forceinline__ void done(const Unit&) const {}
};

template <class Epi, class Sched, bool ALIGN_EPI = false, bool SP2 = false, bool GATHER = false>
__device__ __forceinline__ void gemm_phase(PG8_LAS unsigned char* lds, const Gemm g, const Sched& S, const Epi& E, const PG8_LAS int* rowtok = nullptr) {
    int tid_ = threadIdx.x; asm volatile("" : "+v"(tid_));
    const int tid = tid_, wid = __builtin_amdgcn_readfirstlane(tid >> 6), lane = tid & 63, wr = wid >> 2, wc = wid & 3, fr = lane & 15, fq = lane >> 4;
    const int K = g.K, nt = K / BK;
    unsigned voffA[2], voffB[2];
#pragma unroll
    for (int i = 0; i < 2; ++i) { int R, C; stage_rc(tid * 16 + i * 8192, R, C); const int Rb = Epi::PERM ? ((R & ~31) + perm32(R & 31)) : R;
        voffA[i] = (unsigned)(R * K + C) * 2u; voffB[i] = (unsigned)(Rb * K + C) * 2u; }
    unsigned gv[2][2] = {{0u, 0u}, {0u, 0u}};
#define PG8_GV(dst, u) do { if constexpr (GATHER) { _Pragma("unroll") for (int i_ = 0; i_ < 2; ++i_) { int R_, C_; stage_rc(tid * 16 + i_ * 8192, R_, C_); _Pragma("unroll") for (int h_ = 0; h_ < 2; ++h_) \
        dst[h_][i_] = (unsigned)(rowtok[(u).ui * BM + h_ * HALF + R_] * K + C_) * 2u; } } } while (0)
    const size_t kstep = (size_t)(BK * 2);
    const size_t hstep = (size_t)HALF * K * 2;
    const size_t tstep = 2 * hstep;
    const unsigned ldsw = (unsigned)wid * 1024u;
    const int aoff = lds_byte(wr * 64 + fr, fq * 8), boff = lds_byte(wc * 32 + fr, fq * 8);
#define PG8_SA(b, h) (((b) * 2 + (h)) * HTB)
#define PG8_SB(b, h) ((4 + (b) * 2 + (h)) * HTB)
#define PG8_STAGE(bufoff, gbase, voff) do { _Pragma("unroll") for (int _i = 0; _i < 2; ++_i) \
        __builtin_amdgcn_global_load_lds((const unsigned*)((const char*)(gbase) + (voff)[_i]), (PG8_LAS unsigned*)(lds + (bufoff) + ldsw + _i * 8192), 16, 0, 0); } while (0)
#define PG8_STA(bufoff, ptr, half, nx) do { if constexpr (GATHER) { unsigned v_[2] = { gv[half][0], gv[half][1] }; \
            if ((nx) && last && has_next_) { _Pragma("unroll") for (int i_ = 0; i_ < 2; ++i_) { int R_, C_; stage_rc(tid * 16 + i_ * 8192, R_, C_); v_[i_] = (unsigned)(rowtok[nxt.ui * BM + (half) * HALF + R_] * K + C_) * 2u; } } \
            PG8_STAGE(bufoff, ptr, v_); } \
        else { PG8_STAGE(bufoff, (ptr) + (half) * hstep, voffA); } } while (0)
#define PG8_LDA(dst, b, h) do { _Pragma("unroll") for (int m = 0; m < 4; ++m) _Pragma("unroll") for (int k = 0; k < 2; ++k) dst[m][k] = *(const PG8_LAS bf16x8*)(lds + PG8_SA(b, h) + aoff + m * 2048 + k * 1024); } while (0)
#define PG8_LDB(dst, b, h) do { _Pragma("unroll") for (int n = 0; n < 2; ++n) _Pragma("unroll") for (int k = 0; k < 2; ++k) dst[n][k] = *(const PG8_LAS bf16x8*)(lds + PG8_SB(b, h) + boff + n * 2048 + k * 1024); } while (0)
#define PG8_MMA(ai, bj, At, Bt) do { __builtin_amdgcn_s_setprio(1); _Pragma("unroll") for (int m = 0; m < 4; ++m) _Pragma("unroll") for (int n = 0; n < 2; ++n) _Pragma("unroll") for (int k = 0; k < 2; ++k) \
        acc[ai][bj][m][n] = __builtin_amdgcn_mfma_f32_16x16x32_bf16(Bt[n][k], At[m][k], acc[ai][bj][m][n], 0, 0, 0); __builtin_amdgcn_s_setprio(0); } while (0)
#define PG8_WAIT_V(n) asm volatile("s_waitcnt vmcnt(" #n ")" ::: "memory")
#define PG8_WAIT_L(n) asm volatile("s_waitcnt lgkmcnt(" #n ")" ::: "memory")
#define PG8_BAR __builtin_amdgcn_s_barrier()
#define PG8_SCHED __builtin_amdgcn_sched_barrier(0)
    Unit cur, nxt; int ui = 0;
    if (!S.next(0, cur)) return;
    f32x4 acc[2][2][4][2];
#pragma unroll
    for (int a = 0; a < 2; ++a)
#pragma unroll
        for (int b = 0; b < 2; ++b)
#pragma unroll
            for (int m = 0; m < 4; ++m)
#pragma unroll
                for (int n = 0; n < 2; ++n) acc[a][b][m][n] = (f32x4){0.f, 0.f, 0.f, 0.f};
    bf16x8 At[4][2], B0[2][2], B1[2][2];
    const char* cA = (const char*)g.A + (GATHER ? (size_t)0 : (size_t)cur.pm * tstep); const char* cB = (const char*)g.Bt + (size_t)cur.pb * tstep;
    PG8_GV(gv, cur);
    S.a_ready(cur);
    if constexpr (SP2) {
        { constexpr bool last = false, has_next_ = false; PG8_STAGE(PG8_SB(0, 0), cB, voffB); PG8_STAGE(PG8_SB(0, 1), cB + hstep, voffB); PG8_STA(PG8_SA(0, 0), cA, 0, false); PG8_STA(PG8_SA(0, 1), cA, 1, false); }
        if (wr == 1) PG8_BAR;
        PG8_WAIT_V(2); PG8_BAR;
        { constexpr bool last = false, has_next_ = false; PG8_STAGE(PG8_SB(1, 0), cB + kstep, voffB); PG8_STA(PG8_SA(1, 0), cA + kstep, 0, false); PG8_STAGE(PG8_SB(1, 1), cB + hstep + kstep, voffB); }
        PG8_WAIT_V(6); PG8_BAR;
    } else {
        PG8_STAGE(PG8_SB(0, 0), cB, voffB); PG8_STAGE(PG8_SA(0, 0), cA, voffA); PG8_STAGE(PG8_SB(0, 1), cB + hstep, voffB); PG8_STAGE(PG8_SA(0, 1), cA + hstep, voffA);
        if (wr == 1) PG8_BAR;
        PG8_WAIT_V(4); PG8_BAR;
        PG8_STAGE(PG8_SB(1, 0), cB + kstep, voffB); PG8_STAGE(PG8_SA(1, 0), cA + kstep, voffA); PG8_STAGE(PG8_SB(1, 1), cB + hstep + kstep, voffB);
        PG8_WAIT_V(6); PG8_BAR;
    }
    for (;;) {
        const bool has_next = S.next(ui + 1, nxt);
        const char* nA = has_next ? (const char*)g.A + (GATHER ? (size_t)0 : (size_t)nxt.pm * tstep) : cA; const char* nB = has_next ? (const char*)g.Bt + (size_t)nxt.pb * tstep : cB;
        const bool has_next_ = has_next;
        for (int t = 0; t < nt; t += 2) {
            const bool last = (t == nt - 2);
            const char* a1 = cA + (size_t)(t + 1) * kstep;
            const char* a2 = last ? nA : cA + (size_t)(t + 2) * kstep; const char* b2 = last ? nB : cB + (size_t)(t + 2) * kstep;
            const char* a3 = a2 + kstep; const char* b3 = b2 + kstep;
            if (last && has_next) S.a_ready(nxt);
            if constexpr (SP2) {
            PG8_LDB(B0, 0, 0); PG8_LDB(B1, 0, 1); PG8_SCHED; PG8_LDA(At, 0, 0); PG8_STA(PG8_SA(1, 1), a1, 1, false);
            PG8_WAIT_V(8); PG8_WAIT_L(0); PG8_BAR; PG8_MMA(0, 0, At, B0); PG8_MMA(0, 1, At, B1); PG8_BAR; PG8_SCHED;
            PG8_LDA(At, 0, 1); PG8_STAGE(PG8_SB(0, 0), b2, voffB); PG8_STAGE(PG8_SB(0, 1), b2 + hstep, voffB); PG8_STA(PG8_SA(0, 0), a2, 0, true);
            PG8_WAIT_V(8); PG8_WAIT_L(0); PG8_BAR; PG8_MMA(1, 0, At, B0); PG8_MMA(1, 1, At, B1); PG8_BAR; PG8_SCHED;
            PG8_LDB(B0, 1, 0); PG8_LDB(B1, 1, 1); PG8_SCHED; PG8_LDA(At, 1, 0); PG8_STA(PG8_SA(0, 1), a2, 1, true);
            PG8_WAIT_V(8); PG8_WAIT_L(0); PG8_BAR; PG8_MMA(0, 0, At, B0); PG8_MMA(0, 1, At, B1); PG8_BAR; PG8_SCHED;
            PG8_LDA(At, 1, 1); PG8_STAGE(PG8_SB(1, 0), b3, voffB); PG8_STAGE(PG8_SB(1, 1), b3 + hstep, voffB); PG8_STA(PG8_SA(1, 0), a3, 0, true);
            PG8_WAIT_V(8); PG8_WAIT_L(0); PG8_BAR; PG8_MMA(1, 0, At, B0); PG8_MMA(1, 1, At, B1); PG8_BAR; PG8_SCHED;
            } else {
            PG8_LDB(B0, 0, 0); PG8_SCHED; PG8_LDA(At, 0, 0); PG8_STAGE(PG8_SA(1, 1), a1 + hstep, voffA);
            PG8_WAIT_L(8); PG8_BAR; PG8_WAIT_L(0); PG8_MMA(0, 0, At, B0); PG8_BAR; PG8_SCHED;
            PG8_LDB(B1, 0, 1); PG8_STAGE(PG8_SB(0, 0), b2, voffB);
            PG8_BAR; PG8_WAIT_L(0); PG8_MMA(0, 1, At, B1); PG8_BAR;
            PG8_LDA(At, 0, 1); PG8_STAGE(PG8_SA(0, 0), a2, voffA);
            PG8_BAR; PG8_WAIT_L(0); PG8_MMA(1, 0, At, B0); PG8_BAR; PG8_SCHED;
            PG8_STAGE(PG8_SB(0, 1), b2 + hstep, voffB);
            PG8_WAIT_V(6); PG8_BAR; PG8_MMA(1, 1, At, B1); PG8_BAR;
            PG8_LDB(B0, 1, 0); PG8_SCHED; PG8_LDA(At, 1, 0); PG8_STAGE(PG8_SA(0, 1), a2 + hstep, voffA);
            PG8_WAIT_L(8); PG8_BAR; PG8_WAIT_L(0); PG8_MMA(0, 0, At, B0); PG8_BAR; PG8_SCHED;
            PG8_LDB(B1, 1, 1); PG8_STAGE(PG8_SB(1, 0), b3, voffB);
            PG8_BAR; PG8_WAIT_L(0); PG8_MMA(0, 1, At, B1); PG8_BAR;
            PG8_LDA(At, 1, 1); PG8_STAGE(PG8_SA(1, 0), a3, voffA);
            PG8_BAR; PG8_WAIT_L(0); PG8_MMA(1, 0, At, B0); PG8_BAR; PG8_SCHED;
            PG8_STAGE(PG8_SB(1, 1), b3 + hstep, voffB);
            PG8_WAIT_V(6); PG8_BAR; PG8_MMA(1, 1, At, B1); PG8_BAR;
            }
        }
        if constexpr (ALIGN_EPI) { if (wr == 0) PG8_BAR; }
        if constexpr (!Epi::AFTER_DRAIN) { E(acc, cur, wr, wc, fr, fq); S.done(cur); }
        if (!has_next) break;
#pragma unroll
        for (int a = 0; a < 2; ++a)
#pragma unroll
            for (int b = 0; b < 2; ++b)
#pragma unroll
                for (int m = 0; m < 4; ++m)
#pragma unroll
                    for (int n = 0; n < 2; ++n) acc[a][b][m][n] = (f32x4){0.f, 0.f, 0.f, 0.f};
        cur = nxt; cA = nA; cB = nB; ++ui;
        PG8_GV(gv, cur);
        if constexpr (ALIGN_EPI) { if (wr == 1) PG8_BAR; }
    }
    PG8_WAIT_V(0);
    if constexpr (!ALIGN_EPI) { if (wr == 0) PG8_BAR; }
    PG8_BAR;
    if constexpr (Epi::AFTER_DRAIN) { E.fused(acc, cur, wr, wc, fr, fq, lds, wid, lane); S.done(cur); }
#undef PG8_SA
#undef PG8_SB
#undef PG8_STAGE
#undef PG8_LDA
#undef PG8_STA
#undef PG8_GV
#undef PG8_LDB
#undef PG8_MMA
#undef PG8_WAIT_V
#undef PG8_WAIT_L
#undef PG8_BAR
#undef PG8_SCHED
}
}

namespace att {
using bf16 = bf16_t;
constexpr int   D = 128, NW = 8, QBLK = 32, KVBLK = 64;
constexpr float SCALE = 0.125f;
constexpr float THR = 8.f;
constexpr int SDEPTH = 2;
constexpr int LDQ = ABIN, LDK = ABIN, LDO = 2 * NDH * VD;
constexpr size_t SHM_V = KVBLK * D * 2, SHM_K = KVBLK * D * 2, SHM_ATTN = 2 * SHM_V + 2 * SHM_K + NW * 64 * 4;
using bf16x8 = __attribute__((ext_vector_type(8))) short;
using s16x4  = __attribute__((ext_vector_type(4))) short;
using f32x16 = __attribute__((ext_vector_type(16))) float;
using f32x8  = __attribute__((ext_vector_type(8))) float;
using u32x4  = __attribute__((ext_vector_type(4))) unsigned;
#define KSWZ(row, colB) ((row) * 256 + ((colB) ^ (((row) & 7) << 4)))
#define SBAR() __builtin_amdgcn_sched_barrier(0)
__device__ __forceinline__ int crow(int r, int hi) { return (r & 3) + 8 * (r >> 2) + 4 * hi; }
__device__ __forceinline__ unsigned cvtpk(float lo, float hi) {
  unsigned r; asm volatile("v_cvt_pk_bf16_f32 %0, %1, %2" : "=v"(r) : "v"(lo), "v"(hi)); return r;
}
struct St { using T = bf16x8;
  __device__ static __forceinline__ T ld8(const bf16* p) { return *reinterpret_cast<const bf16x8*>(p); }
  __device__ static __forceinline__ bf16x8 tobf(T x) { return x; } };

__device__ __forceinline__ void partialSM(f32x16& p0, f32x16& p1, float& m_reg, float& mn, float& alpha) {
  constexpr float C = SCALE * 1.4426950408889634f;
  float pmax = p0[0]; for (int r = 1; r < 16; ++r) pmax = fmaxf(pmax, p0[r]); for (int r = 0; r < 16; ++r) pmax = fmaxf(pmax, p1[r]);
  { auto rr = __builtin_amdgcn_permlane32_swap(__float_as_uint(pmax), __float_as_uint(pmax), false, false);
    pmax = fmaxf(__uint_as_float(rr[0]), __uint_as_float(rr[1])); }
  if (__builtin_expect(__all(pmax - m_reg <= THR / SCALE), 1)) { mn = m_reg; alpha = 1.f; }
  else { mn = fmaxf(m_reg, pmax); alpha = __builtin_amdgcn_exp2f((m_reg - mn) * C); m_reg = mn; }
  float mnC = -mn * C;
  for (int r = 0; r < 16; ++r) p0[r] = fmaf(p0[r], C, mnC); for (int r = 0; r < 16; ++r) p1[r] = fmaf(p1[r], C, mnC);
  for (int r = 0; r < 16; ++r) p0[r] = __builtin_amdgcn_exp2f(p0[r]);
}
__device__ __forceinline__ void finishSM(f32x16& p0, f32x16& p1, float alpha, float& l_reg, bf16x8& pa0, bf16x8& pa1, bf16x8& pa2, bf16x8& pa3) {
  for (int r = 0; r < 16; ++r) p1[r] = __builtin_amdgcn_exp2f(p1[r]);
  float ps = 0; for (int r = 0; r < 16; ++r) ps += p0[r]; for (int r = 0; r < 16; ++r) ps += p1[r];
  { auto rr = __builtin_amdgcn_permlane32_swap(__float_as_uint(ps), __float_as_uint(ps), false, false);
    ps = __uint_as_float(rr[0]) + __uint_as_float(rr[1]); }
  l_reg = l_reg * alpha + ps;
#define PK4(P, BASE, OUT) do { unsigned a0 = cvtpk(P[BASE + 0], P[BASE + 1]), a1 = cvtpk(P[BASE + 2], P[BASE + 3]);   \
    unsigned b0 = cvtpk(P[BASE + 4], P[BASE + 5]), b1 = cvtpk(P[BASE + 6], P[BASE + 7]);                              \
    auto r0 = __builtin_amdgcn_permlane32_swap(a0, b0, false, false); auto r1 = __builtin_amdgcn_permlane32_swap(a1, b1, false, false); \
    u32x4 w = {r0[0], r1[0], r0[1], r1[1]}; OUT = *reinterpret_cast<bf16x8*>(&w); } while (0)
  PK4(p0, 0, pa0); PK4(p0, 8, pa1); PK4(p1, 0, pa2); PK4(p1, 8, pa3);
#undef PK4
}
__device__ __forceinline__ void qkt(f32x16& p0, f32x16& p1, const bf16* Ks, const bf16x8* qr, int r32, int hi, int cbase) {
  p0 = f32x16{}; p1 = f32x16{};
#pragma unroll
  for (int d0 = 0; d0 < 4; ++d0) { int cb = cbase + (d0 * 16 + hi * 8) * 2;
    bf16x8 b0 = *reinterpret_cast<const bf16x8*>((const char*)Ks + KSWZ(r32, cb));
    bf16x8 b1 = *reinterpret_cast<const bf16x8*>((const char*)Ks + KSWZ(32 + r32, cb));
    p0 = __builtin_amdgcn_mfma_f32_32x32x16_bf16(b0, qr[d0], p0, 0, 0, 0);
    p1 = __builtin_amdgcn_mfma_f32_32x32x16_bf16(b1, qr[d0], p1, 0, 0, 0); }
}
__device__ __forceinline__ int v_st(int k, int c) { const int kk = (k & ~0xC) | ((k & 4) << 1) | ((k & 8) >> 1); return ((kk >> 3) * 4 + (c >> 5)) * 512 + ((kk & 7) * 32 + (c & 31)) * 2; }
__device__ __forceinline__ int v_rd_base(int lane) { return ((lane & 3) << 3) | (((lane >> 2) & 3) << 6) | (((lane >> 4) & 1) << 5) | (((lane >> 5) & 1) << 8); }
constexpr int v_rd_off(int d0, int ks, int half) { return d0 * 512 + ks * 4096 + half * 2048; }
template <int OFF> __device__ __forceinline__ s16x4 tr_read(int vb) {
  s16x4 r; asm volatile("ds_read_b64_tr_b16 %0, %1 offset:%2" : "=&v"(r) : "v"(vb), "i"(OFF) : "memory"); return r;
}
template <int D0> __device__ __forceinline__ void pv_one(f32x16& od, int vb, bf16x8 pa0, bf16x8 pa1, bf16x8 pa2, bf16x8 pa3) {
  const s16x4 l0 = tr_read<v_rd_off(D0, 0, 0)>(vb), h0 = tr_read<v_rd_off(D0, 0, 1)>(vb), l1 = tr_read<v_rd_off(D0, 1, 0)>(vb), h1 = tr_read<v_rd_off(D0, 1, 1)>(vb);
  const s16x4 l2 = tr_read<v_rd_off(D0, 2, 0)>(vb), h2 = tr_read<v_rd_off(D0, 2, 1)>(vb), l3 = tr_read<v_rd_off(D0, 3, 0)>(vb), h3 = tr_read<v_rd_off(D0, 3, 1)>(vb);
  asm volatile("s_waitcnt lgkmcnt(0)" ::: "memory"); SBAR();
#define PK(L, H) (bf16x8){L[0], L[1], L[2], L[3], H[0], H[1], H[2], H[3]}
  od = __builtin_amdgcn_mfma_f32_32x32x16_bf16(pa0, PK(l0, h0), od, 0, 0, 0);
  od = __builtin_amdgcn_mfma_f32_32x32x16_bf16(pa1, PK(l1, h1), od, 0, 0, 0);
  od = __builtin_amdgcn_mfma_f32_32x32x16_bf16(pa2, PK(l2, h2), od, 0, 0, 0);
  od = __builtin_amdgcn_mfma_f32_32x32x16_bf16(pa3, PK(l3, h3), od, 0, 0, 0);
#undef PK
}
__device__ __forceinline__ void pv_d0(f32x16* o, int vb, bf16x8 pa0, bf16x8 pa1, bf16x8 pa2, bf16x8 pa3) {
  pv_one<0>(o[0], vb, pa0, pa1, pa2, pa3); pv_one<1>(o[1], vb, pa0, pa1, pa2, pa3); pv_one<2>(o[2], vb, pa0, pa1, pa2, pa3); pv_one<3>(o[3], vb, pa0, pa1, pa2, pa3);
}

__device__ __forceinline__ void attn_dense_body(const bf16* __restrict__ Qb, const bf16* __restrict__ Kh, const bf16* __restrict__ Vh,
                                                float* __restrict__ Ob, int seq, char* lds, int cbase) {
  using SQ = St;
  int tid_ = threadIdx.x; asm volatile("" : "+v"(tid_));
  const int tid = tid_, wid = tid >> 6, lane = tid & 63, r32 = lane & 31, hi = lane >> 5;
  bf16* V_lds = (bf16*)lds; bf16* K_lds = (bf16*)(lds + 2 * SHM_V);
  float* ws = (float*)(lds + 2 * SHM_V + 2 * SHM_K) + wid * 64; float* li_l = ws; float* al_l = ws + 32;
  float m_reg = -1e30f, l_reg = 0; f32x16 o[4] = {}; bf16x8 qr[4];
  const bf16* Qw = Qb + (long)(wid * QBLK + r32) * LDQ + hi * 8;
#pragma unroll
  for (int d0 = 0; d0 < 4; ++d0) qr[d0] = SQ::tobf(SQ::ld8(Qw + d0 * 16));
  const int sr = tid >> 4, sc = (tid & 15) * 8, vst0 = v_st(sr, sc), vst1 = v_st(32 + sr, sc);
  const int vb0 = (int)(uintptr_t)V_lds + v_rd_base(lane);
  struct { typename St::T vs0, vs1, ks0, ks1; } sr_[SDEPTH];
#define SLOAD(i, k0) do { sr_[i].vs0 = St::ld8(&Vh[(long)((k0) + sr) * LDK + sc]); sr_[i].vs1 = St::ld8(&Vh[(long)((k0) + 32 + sr) * LDK + sc]); \
    sr_[i].ks0 = St::ld8(&Kh[(long)((k0) + sr) * LDK + sc]); sr_[i].ks1 = St::ld8(&Kh[(long)((k0) + 32 + sr) * LDK + sc]); } while (0)
#define SWRITE(b, i) do { *(bf16x8*)((char*)V_lds + (b) * SHM_V + vst0) = St::tobf(sr_[i].vs0);          \
    *(bf16x8*)((char*)V_lds + (b) * SHM_V + vst1) = St::tobf(sr_[i].vs1); int kc = sc * 2;               \
    *(bf16x8*)((char*)K_lds + (b) * SHM_K + KSWZ(sr, kc)) = St::tobf(sr_[i].ks0);                       \
    *(bf16x8*)((char*)K_lds + (b) * SHM_K + KSWZ(32 + sr, kc)) = St::tobf(sr_[i].ks1); } while (0)
#define SWAIT() do { if constexpr (SDEPTH == 2) asm volatile("s_waitcnt vmcnt(4)" ::: "memory"); else asm volatile("s_waitcnt vmcnt(0)" ::: "memory"); } while (0)
#define RESC(a) do { if (__any((a) < 1.f)) { if (hi == 0) al_l[r32] = (a); asm volatile("s_waitcnt lgkmcnt(0)" ::: "memory"); \
    for (int d = 0; d < 4; ++d) for (int r = 0; r < 16; ++r) o[d][r] *= al_l[crow(r, hi)]; } } while (0)
  f32x16 pA0, pA1, pB0, pB1; float mnA, mnB, alA, alB; bf16x8 pa0, pa1, pa2, pa3; const int NT = seq / KVBLK;
  constexpr int SE = 0, SO = SDEPTH - 1;
  SLOAD(SE, 0); asm volatile("s_waitcnt vmcnt(0)" ::: "memory"); SWRITE(0, SE); __syncthreads();
  qkt(pA0, pA1, K_lds, qr, r32, hi, cbase); partialSM(pA0, pA1, m_reg, mnA, alA);
  SLOAD(SO, KVBLK); if constexpr (SDEPTH == 2) { if (2 < NT) SLOAD(SE, 2 * KVBLK); }
  SWAIT(); SWRITE(1, SO); __syncthreads();
  for (int j = 1; j + 1 < NT; j += 2) {
    SBAR(); qkt(pB0, pB1, (bf16*)((char*)K_lds + SHM_K), qr, r32, hi, cbase);
    finishSM(pA0, pA1, alA, l_reg, pa0, pa1, pa2, pa3); SBAR();
    SLOAD(SO, (j + SDEPTH) * KVBLK); SBAR();
    pv_d0(o, vb0, pa0, pa1, pa2, pa3); partialSM(pB0, pB1, m_reg, mnB, alB);
    __syncthreads(); SWAIT(); SWRITE(0, SE);
    RESC(alB); __syncthreads();
    SBAR(); qkt(pA0, pA1, K_lds, qr, r32, hi, cbase);
    finishSM(pB0, pB1, alB, l_reg, pa0, pa1, pa2, pa3); SBAR();
    if (SDEPTH == 1 || j + 3 < NT) SLOAD(SE, (j + 1 + SDEPTH) * KVBLK); SBAR();
    pv_d0(o, vb0 + (int)SHM_V, pa0, pa1, pa2, pa3); partialSM(pA0, pA1, m_reg, mnA, alA);
    __syncthreads(); SWAIT(); SWRITE(1, SO);
    RESC(alA); __syncthreads();
  }
  SBAR(); qkt(pB0, pB1, (bf16*)((char*)K_lds + SHM_K), qr, r32, hi, cbase);
  finishSM(pA0, pA1, alA, l_reg, pa0, pa1, pa2, pa3); SBAR();
  pv_d0(o, vb0, pa0, pa1, pa2, pa3); partialSM(pB0, pB1, m_reg, mnB, alB);
  __syncthreads(); RESC(alB);
  finishSM(pB0, pB1, alB, l_reg, pa0, pa1, pa2, pa3); SBAR();
  pv_d0(o, vb0 + (int)SHM_V, pa0, pa1, pa2, pa3);
  if (hi == 0) li_l[r32] = l_reg; asm volatile("s_waitcnt lgkmcnt(0)" ::: "memory");
  float rli[16];
#pragma unroll
  for (int r = 0; r < 16; ++r) rli[r] = __builtin_amdgcn_rcpf(li_l[crow(r, hi)]);
  float* Ow = Ob + (long)(wid * QBLK) * LDO;
#pragma unroll
  for (int r = 0; r < 16; ++r) { int orow = crow(r, hi);
    for (int d0 = 0; d0 < 4; ++d0) Ow[(long)orow * LDO + d0 * 32 + r32] = o[d0][r] * rli[r]; }
#undef SLOAD
#undef SWRITE
#undef SWAIT
#undef RESC
}


__device__ __forceinline__ void attn_combine(const float* O1, const float* O2, float lam, float nscale, const float* __restrict__ sg, bf16* __restrict__ Cb, int ldc) {
  int tid_ = threadIdx.x; asm volatile("" : "+v"(tid_));
  const int wid = tid_ >> 6, lane = tid_ & 63, r32 = lane & 31, hi = lane >> 5;
  const float* W1 = O1 + (long)(wid * QBLK) * LDO; const float* W2 = O2 + (long)(wid * QBLK) * LDO; bf16* Cw = Cb + (long)(wid * QBLK) * ldc;
  float sgv[4];
#pragma unroll
  for (int d0 = 0; d0 < 4; ++d0) sgv[d0] = sg[d0 * 32 + r32] * nscale;
#pragma unroll 4
  for (int r = 0; r < 16; ++r) { const int orow = crow(r, hi); float v[4]; float ss = 0.f;
#pragma unroll
    for (int d0 = 0; d0 < 4; ++d0) { v[d0] = W1[(long)orow * LDO + d0 * 32 + r32] - lam * W2[(long)orow * LDO + d0 * 32 + r32]; ss += v[d0] * v[d0]; }
#pragma unroll
    for (int x = 1; x < 32; x <<= 1) ss += __shfl_xor(ss, x);
    const float rs = 1.f / sqrtf(ss * (1.f / 128.f) + 1e-6f);
#pragma unroll
    for (int d0 = 0; d0 < 4; ++d0) { const float q = v[d0] * rs * sgv[d0]; Cw[(long)orow * ldc + d0 * 32 + r32] = (bf16)cvtpk(q, q); } }
}

}

namespace ssd {
using att::bf16x8; using att::f32x16; using att::cvtpk; using att::crow;
typedef short s16x4 __attribute__((ext_vector_type(4)));
constexpr int CH = 128, NC = TPB / CH;
constexpr int IMG_B = 0, IMG_C = 32768, IMG_X = 65536, IMG_S = 98304, ARR = 114688, ARR_STRIDE = 4096, PART = 122880;
constexpr int SSD_LDS_END = PART + 16384;
constexpr float LOG2E = 1.4426950408889634f;
__device__ __forceinline__ unsigned offb(unsigned row, unsigned ch) { return 256u * row + 16u * (ch ^ (((row & 3u) << 2) | ((row >> 2) & 3u))); }
__device__ __forceinline__ unsigned row_addr(unsigned lane, unsigned rb, unsigned s) { return offb(32u * rb + (lane & 31u), 2u * s + (lane >> 5)); }
__device__ __forceinline__ unsigned tr_addr(unsigned lane, unsigned c, unsigned ks, unsigned t) {
    const unsigned h = lane >> 5, blk = (lane >> 4) & 1u, q = (lane & 15u) >> 2, pp = lane & 3u;
    return offb(16u * ks + 8u * h + 4u * t + q, 4u * c + 2u * blk + (pp >> 1)) + 8u * (pp & 1u);
}
__device__ __forceinline__ s16x4 tr_rd(unsigned a) { s16x4 r; asm volatile("ds_read_b64_tr_b16 %0, %1" : "=v"(r) : "v"(a) : "memory"); return r; }
template <int OFF> __device__ __forceinline__ s16x4 tr_rdo(unsigned a) { s16x4 r; asm volatile("ds_read_b64_tr_b16 %0, %1 offset:%2" : "=v"(r) : "v"(a), "i"(OFF) : "memory"); return r; }
__device__ __forceinline__ unsigned row_base(unsigned lane) { return row_addr(lane, 0, 0); }
__device__ __forceinline__ unsigned tr_base(unsigned lane, unsigned t) { return tr_addr(lane, 0, 0, t); }
__device__ __forceinline__ int tok_of(int dir, int q) { const int fl = (q < CTX ? CTX - 1 : TPB + CTX - 1) - q; return dir ? fl : q; }
#define SSD_PK4(P, BASE, OUT) do { unsigned a0 = cvtpk(P[BASE + 0], P[BASE + 1]), a1 = cvtpk(P[BASE + 2], P[BASE + 3]);   \
    unsigned b0 = cvtpk(P[BASE + 4], P[BASE + 5]), b1 = cvtpk(P[BASE + 6], P[BASE + 7]);                              \
    auto r0 = __builtin_amdgcn_permlane32_swap(a0, b0, false, false); auto r1 = __builtin_amdgcn_permlane32_swap(a1, b1, false, false); \
    att::u32x4 w = {r0[0], r1[0], r0[1], r1[1]}; OUT = *reinterpret_cast<bf16x8*>(&w); } while (0)

__device__ __forceinline__ void ssd_unit(const Prm& p, int ih, int b, int dir, int h, LAS unsigned char* lds) {
    int tid_ = threadIdx.x; asm volatile("" : "+v"(tid_));
    const int tid = tid_, wave = __builtin_amdgcn_readfirstlane(tid >> 6), lane = tid & 63, r32 = lane & 31, hi = lane >> 5;
    const int g = h / SSD_E;
    const float A2 = -expf(p.in[I_SSDALOG][(size_t)ih * 2 * SSD_H + dir * SSD_H + h]) * LOG2E;
    const char* XBCb = (const char*)WSP(const bf16_t, WS_XBC); const float* DT = WSP(const float, WS_DT);
    char* Yb = (char*)(WSP(bf16_t, WS_YS) + (size_t)dir * R * SSD_DI);
    const unsigned L = (unsigned)(uintptr_t)lds;
    const int rowb = b * TPB, sgn = dir ? -1 : 1;
    const int sB = tid >> 4, sX = tid >> 3;
    const unsigned gB0 = (unsigned)(rowb + sgn * sB) * (unsigned)(SSD_CC * 2) + (unsigned)((SSD_DI + g * SSD_N + (tid & 15) * 8) * 2);
    const unsigned gX0 = (unsigned)(rowb + sgn * sX) * (unsigned)(SSD_CC * 2) + (unsigned)((h * SSD_P + (tid & 7) * 8) * 2);
    const int gstepB = sgn * 32 * SSD_CC * 2, gstepX = sgn * 64 * SSD_CC * 2;
    const unsigned wB0 = offb(sB, tid & 15), wX0 = offb(sX, tid & 7), wXW0 = offb(sX, 8 + (tid & 7));
    att::u32x4 rB[4], rC[4], rX[2];
#define SSD_LOAD(c) do { const unsigned t0_ = (unsigned)(tok_of(dir, (c) * CH) * (SSD_CC * 2)); \
        _Pragma("unroll") for (int i = 0; i < 4; ++i) { const unsigned o_ = gB0 + t0_ + (unsigned)(i * gstepB); rB[i] = *(const att::u32x4*)(XBCb + o_); rC[i] = *(const att::u32x4*)(XBCb + o_ + SSD_G * SSD_N * 2); } \
        _Pragma("unroll") for (int i = 0; i < 2; ++i) { const unsigned o_ = gX0 + t0_ + (unsigned)(i * gstepX); rX[i] = *(const att::u32x4*)(XBCb + o_); } } while (0)
#define SSD_WRITE(c) do { const LAS float* wv_ = (const LAS float*)(lds + ARR + ((c) & 1) * ARR_STRIDE) + 256; \
        _Pragma("unroll") for (int i = 0; i < 4; ++i) { *(LAS att::u32x4*)(lds + IMG_B + wB0 + 8192 * i) = rB[i]; *(LAS att::u32x4*)(lds + IMG_C + wB0 + 8192 * i) = rC[i]; } \
        _Pragma("unroll") for (int i = 0; i < 2; ++i) { *(LAS att::u32x4*)(lds + IMG_X + wX0 + 16384 * i) = rX[i]; const float w_ = wv_[sX + 64 * i]; \
            att::u32x4 q_; q_.x = cvtpk(__uint_as_float(rX[i].x << 16) * w_, __uint_as_float(rX[i].x & 0xffff0000u) * w_); q_.y = cvtpk(__uint_as_float(rX[i].y << 16) * w_, __uint_as_float(rX[i].y & 0xffff0000u) * w_); \
            q_.z = cvtpk(__uint_as_float(rX[i].z << 16) * w_, __uint_as_float(rX[i].z & 0xffff0000u) * w_); q_.w = cvtpk(__uint_as_float(rX[i].w << 16) * w_, __uint_as_float(rX[i].w & 0xffff0000u) * w_); \
            *(LAS att::u32x4*)(lds + IMG_X + wXW0 + 16384 * i) = q_; } } while (0)
    float sd0 = 0.f, sd1 = 0.f;
#define SSD_DTLOAD(c) do { if (wave == 0) { const int t0_ = rowb + tok_of(dir, (c) * CH); sd0 = DT[(size_t)(t0_ + sgn * (2 * lane)) * 2 * SSD_H + dir * SSD_H + h]; sd1 = DT[(size_t)(t0_ + sgn * (2 * lane + 1)) * 2 * SSD_H + dir * SSD_H + h]; } } while (0)
#define SSD_SCAN(c) do { if (wave == 0) { LAS float* ar = (LAS float*)(lds + ARR + ((c) & 1) * ARR_STRIDE); const float d0 = sd0, d1 = sd1; \
            const float a0 = d0 * A2, a1 = d1 * A2; float v = a0 + a1; \
            _Pragma("unroll") for (int o = 1; o < 64; o <<= 1) { const float tq = __shfl_up(v, o); if (lane >= o) v += tq; } \
            const float tot = __shfl(v, 63), c1 = v, c0 = v - a1; \
            ar[2 * lane] = c0; ar[2 * lane + 1] = c1; ar[128 + 2 * lane] = c0 - __builtin_amdgcn_logf(d0); ar[128 + 2 * lane + 1] = c1 - __builtin_amdgcn_logf(d1); \
            ar[256 + 2 * lane] = d0 * __builtin_amdgcn_exp2f(tot - c0); ar[256 + 2 * lane + 1] = d1 * __builtin_amdgcn_exp2f(tot - c1); \
            ar[384 + 2 * lane] = __builtin_amdgcn_exp2f(c0); ar[384 + 2 * lane + 1] = __builtin_amdgcn_exp2f(c1); if (lane == 0) ar[512] = __builtin_amdgcn_exp2f(tot); } } while (0)

    const bool isB = wave >= 4; const int lb = isB ? 7 - wave : wave, pb = wave >> 2, nb = wave & 3;
    const unsigned ra0 = L + row_base(lane);
    const unsigned tb0 = L + tr_base(lane, 0), tb1 = L + tr_base(lane, 1);
    const unsigned vx00 = IMG_X + tb0, vx01 = IMG_X + tb1, vx10 = IMG_X + (tb0 ^ 64u), vx11 = IMG_X + (tb1 ^ 64u);
    const unsigned vw0 = IMG_X + (tb0 ^ (64u * (2 + pb))), vw1 = IMG_X + (tb1 ^ (64u * (2 + pb)));
    const unsigned vb0 = IMG_B + (tb0 ^ (64u * nb)), vb1 = IMG_B + (tb1 ^ (64u * nb));
    const unsigned sw0 = IMG_S + 8192u * pb + 1024u * hi + 16u * ((unsigned)(4 * nb + (r32 >> 3)) ^ (unsigned)hi) + 2u * (r32 & 7);
    const unsigned yo0 = (unsigned)((rowb + sgn * (32 * lb + 4 * hi)) * SSD_DI + h * SSD_P + r32) * 2u;
    const int ystep = sgn * SSD_DI * 2;
    unsigned rak[8];
#pragma unroll
    for (int kn = 0; kn < 8; ++kn) rak[kn] = ra0 ^ (32u * kn);
#define SSD_ROWRD(img, rb, kn) (*(const LAS bf16x8*)(uintptr_t)(rak[kn] + (unsigned)(img) + 8192u * (unsigned)(rb)))
    f32x16 S = {};
    *(LAS att::u32x4*)(lds + IMG_S + tid * 16) = (att::u32x4){0u, 0u, 0u, 0u}; *(LAS att::u32x4*)(lds + IMG_S + 8192 + tid * 16) = (att::u32x4){0u, 0u, 0u, 0u};
    SSD_LOAD(0); SSD_DTLOAD(0); SSD_SCAN(0);
    __syncthreads();
    SSD_WRITE(0);
    __syncthreads();
#pragma unroll 1
    for (int c = 0; c < NC; ++c) {
        if (c + 1 < NC) { SSD_LOAD(c + 1); SSD_DTLOAD(c + 1); }
        const LAS float* arr = (const LAS float*)(lds + ARR + (c & 1) * ARR_STRIDE);
        f32x16 yd0 = {}, yd1 = {};
        bf16x8 cf[8];
#pragma unroll
        for (int kn = 0; kn < 8; ++kn) cf[kn] = SSD_ROWRD(IMG_C, lb, kn);
        const float csl = arr[32 * lb + r32];
#pragma unroll 1
        for (int sb = lb - (isB ? 1 : 0); sb >= 0; sb -= 2) {
            f32x16 G = {};
#pragma unroll
            for (int kn = 0; kn < 8; ++kn) { const bf16x8 bf = SSD_ROWRD(IMG_B, sb, kn); G = __builtin_amdgcn_mfma_f32_32x32x16_bf16(bf, cf[kn], G, 0, 0, 0); }
            const s16x4 x00 = tr_rd(vx00 + 8192u * sb), x01 = tr_rd(vx01 + 8192u * sb), x02 = tr_rdo<4096>(vx00 + 8192u * sb), x03 = tr_rdo<4096>(vx01 + 8192u * sb);
            const s16x4 x10 = tr_rd(vx10 + 8192u * sb), x11 = tr_rd(vx11 + 8192u * sb), x12 = tr_rdo<4096>(vx10 + 8192u * sb), x13 = tr_rdo<4096>(vx11 + 8192u * sb);
#pragma unroll
            for (int q = 0; q < 4; ++q) { const pg8::f32x4 u4 = *(const LAS pg8::f32x4*)(arr + 128 + 32 * sb + 8 * q + 4 * hi);
#pragma unroll
                for (int i = 0; i < 4; ++i) G[4 * q + i] *= __builtin_amdgcn_exp2f(csl - u4[i]); }
            if (sb == lb) {
#pragma unroll
                for (int q = 0; q < 4; ++q)
#pragma unroll
                    for (int i = 0; i < 4; ++i) G[4 * q + i] = (8 * q + 4 * hi + i > r32) ? 0.f : G[4 * q + i];
            }
            bf16x8 pa0, pa1; SSD_PK4(G, 0, pa0); SSD_PK4(G, 8, pa1);
            asm volatile("s_waitcnt lgkmcnt(0)" ::: "memory"); __builtin_amdgcn_sched_barrier(0);
            yd0 = __builtin_amdgcn_mfma_f32_32x32x16_bf16(pa0, (bf16x8){x00[0], x00[1], x00[2], x00[3], x01[0], x01[1], x01[2], x01[3]}, yd0, 0, 0, 0);
            yd1 = __builtin_amdgcn_mfma_f32_32x32x16_bf16(pa0, (bf16x8){x10[0], x10[1], x10[2], x10[3], x11[0], x11[1], x11[2], x11[3]}, yd1, 0, 0, 0);
            yd0 = __builtin_amdgcn_mfma_f32_32x32x16_bf16(pa1, (bf16x8){x02[0], x02[1], x02[2], x02[3], x03[0], x03[1], x03[2], x03[3]}, yd0, 0, 0, 0);
            yd1 = __builtin_amdgcn_mfma_f32_32x32x16_bf16(pa1, (bf16x8){x12[0], x12[1], x12[2], x12[3], x13[0], x13[1], x13[2], x13[3]}, yd1, 0, 0, 0);
        }
        if (isB) {
            f32x16 yf0 = {}, yf1 = {};
#pragma unroll
            for (int kn = 0; kn < 8; ++kn) { const bf16x8 s0 = SSD_ROWRD(IMG_S, 0, kn), s1 = SSD_ROWRD(IMG_S, 1, kn);
                yf0 = __builtin_amdgcn_mfma_f32_32x32x16_bf16(cf[kn], s0, yf0, 0, 0, 0); yf1 = __builtin_amdgcn_mfma_f32_32x32x16_bf16(cf[kn], s1, yf1, 0, 0, 0); }
#pragma unroll
            for (int q = 0; q < 4; ++q) { const pg8::f32x4 e4 = *(const LAS pg8::f32x4*)(arr + 384 + 32 * lb + 8 * q + 4 * hi);
                att::u32x4 w;
                w.x = cvtpk(yd0[4 * q] + e4[0] * yf0[4 * q], yd0[4 * q + 1] + e4[1] * yf0[4 * q + 1]); w.y = cvtpk(yd0[4 * q + 2] + e4[2] * yf0[4 * q + 2], yd0[4 * q + 3] + e4[3] * yf0[4 * q + 3]);
                w.z = cvtpk(yd1[4 * q] + e4[0] * yf1[4 * q], yd1[4 * q + 1] + e4[1] * yf1[4 * q + 1]); w.w = cvtpk(yd1[4 * q + 2] + e4[2] * yf1[4 * q + 2], yd1[4 * q + 3] + e4[3] * yf1[4 * q + 3]);
                *(LAS att::u32x4*)(lds + PART + lb * 4096 + q * 1024 + lane * 16) = w; }
        }
        { const float dec = arr[512];
#pragma unroll
          for (int r = 0; r < 16; ++r) S[r] *= dec; }
        {
            s16x4 xa[8][2], bb[8][2];
#pragma unroll
            for (int ks = 0; ks < 8; ++ks) { xa[ks][0] = tr_rd(vw0 + 4096u * ks); xa[ks][1] = tr_rd(vw1 + 4096u * ks); bb[ks][0] = tr_rd(vb0 + 4096u * ks); bb[ks][1] = tr_rd(vb1 + 4096u * ks); }
            asm volatile("s_waitcnt lgkmcnt(0)" ::: "memory"); __builtin_amdgcn_sched_barrier(0);
#pragma unroll
            for (int ks = 0; ks < 8; ++ks)
                S = __builtin_amdgcn_mfma_f32_32x32x16_bf16((bf16x8){xa[ks][0][0], xa[ks][0][1], xa[ks][0][2], xa[ks][0][3], xa[ks][1][0], xa[ks][1][1], xa[ks][1][2], xa[ks][1][3]},
                                                           (bf16x8){bb[ks][0][0], bb[ks][0][1], bb[ks][0][2], bb[ks][0][3], bb[ks][1][0], bb[ks][1][1], bb[ks][1][2], bb[ks][1][3]}, S, 0, 0, 0);
        }
        if (c + 1 < NC) SSD_SCAN(c + 1);
        __syncthreads();
        if (!isB) { const unsigned yo = yo0 + (unsigned)(tok_of(dir, c * CH) * (SSD_DI * 2));
#pragma unroll
            for (int q = 0; q < 4; ++q) { const att::u32x4 w = *(const LAS att::u32x4*)(lds + PART + lb * 4096 + q * 1024 + lane * 16);
                const float p0[4] = {__uint_as_float(w.x << 16), __uint_as_float(w.x & 0xffff0000u), __uint_as_float(w.y << 16), __uint_as_float(w.y & 0xffff0000u)};
                const float p1[4] = {__uint_as_float(w.z << 16), __uint_as_float(w.z & 0xffff0000u), __uint_as_float(w.w << 16), __uint_as_float(w.w & 0xffff0000u)};
#pragma unroll
                for (int i = 0; i < 4; ++i) { const float v0 = yd0[4 * q + i] + p0[i], v1 = yd1[4 * q + i] + p1[i]; char* yp = Yb + (yo + (unsigned)((8 * q + i) * ystep));
                    *(bf16_t*)yp = (bf16_t)cvtpk(v0, v0); *(bf16_t*)(yp + 64) = (bf16_t)cvtpk(v1, v1); } } }
#pragma unroll
        for (int r = 0; r < 16; ++r) { constexpr int dummy = 0; (void)dummy; const unsigned xr = (unsigned)(((r & 3) << 2) | ((2 * (r >> 2)) & 2));
            *(LAS bf16_t*)(lds + ((sw0 ^ (16u * xr)) + 256u * (unsigned)((r & 3) + 8 * (r >> 2)))) = (bf16_t)cvtpk(S[r], S[r]); }
        if (c + 1 < NC) SSD_WRITE(c + 1);
        __syncthreads();
    }
#undef SSD_ROWRD
#undef SSD_LOAD
#undef SSD_WRITE
#undef SSD_SCAN
#undef SSD_DTLOAD
}
}

constexpr int NTHR = 512;
constexpr int RING_BYTES = 147456;
constexpr int LDSCTL_OFF = RING_BYTES, MISC_OFF = LDSCTL_OFF + 320;
static_assert(ssd::SSD_LDS_END <= RING_BYTES, "SSD LDS map");
constexpr int LDS_BYTES = 163840;
constexpr int CW_BAR = 4096;

#define GAS __attribute__((address_space(1)))
typedef float f32x4_t __attribute__((ext_vector_type(4)));
typedef unsigned u32x4_t __attribute__((ext_vector_type(4)));
typedef unsigned u32x2_t __attribute__((ext_vector_type(2)));
typedef float f32x2_t __attribute__((ext_vector_type(2)));
__device__ __forceinline__ float wave_sum(float v) {
#pragma unroll
    for (int o = 1; o < 64; o <<= 1) v += __shfl_xor(v, o);
    return v;
}
__device__ __forceinline__ unsigned pk2(float lo, float hi) { unsigned r; asm volatile("v_cvt_pk_bf16_f32 %0, %1, %2" : "=v"(r) : "v"(lo), "v"(hi)); return r; }
__device__ __forceinline__ float bflo(unsigned u) { return __uint_as_float(u << 16); }
__device__ __forceinline__ float bfhi(unsigned u) { return __uint_as_float(u & 0xffff0000u); }
__device__ __forceinline__ float silu_fast(float x) { return x * __builtin_amdgcn_rcpf(1.f + __expf(-x)); }
__device__ __forceinline__ void unpack8f(u32x4_t u, float (&f)[8]) { f[0] = bflo(u.x); f[1] = bfhi(u.x); f[2] = bflo(u.y); f[3] = bfhi(u.y); f[4] = bflo(u.z); f[5] = bfhi(u.z); f[6] = bflo(u.w); f[7] = bfhi(u.w); }
__device__ __forceinline__ u32x4_t pack8f(const float (&f)[8]) { u32x4_t u; u.x = pk2(f[0], f[1]); u.y = pk2(f[2], f[3]); u.z = pk2(f[4], f[5]); u.w = pk2(f[6], f[7]); return u; }

__device__ __forceinline__ void transpose_item(const float* W, int K, int N, bf16_t* WT, int k0, int n0, int drow0, LAS float* scr, int lane) {
    f32x4_t ld[8];
#pragma unroll
    for (int i = 0; i < 8; ++i) ld[i] = *(const f32x4_t*)(W + (size_t)(k0 + 8 * i + (lane >> 3)) * N + n0 + 4 * (lane & 7));
#pragma unroll
    for (int i = 0; i < 8; ++i) { LAS float* d = scr + (8 * i + (lane >> 3)) * 33 + 4 * (lane & 7); d[0] = ld[i].x; d[1] = ld[i].y; d[2] = ld[i].z; d[3] = ld[i].w; }
    asm volatile("s_waitcnt lgkmcnt(0)" ::: "memory");
    const int c = lane & 7;
#pragma unroll
    for (int j = 0; j < 4; ++j) { const int n = (lane >> 3) + 8 * j; const LAS float* s = scr + (8 * c) * 33 + n;
        u32x4_t o; o.x = pk2(s[0 * 33], s[1 * 33]); o.y = pk2(s[2 * 33], s[3 * 33]); o.z = pk2(s[4 * 33], s[5 * 33]); o.w = pk2(s[6 * 33], s[7 * 33]);
        *(u32x4_t*)(WT + (size_t)(drow0 + n) * K + k0 + 8 * c) = o; }
    asm volatile("s_waitcnt lgkmcnt(0)" ::: "memory");
}
__device__ __forceinline__ void transpose_plain(const float* W, int K, int N, bf16_t* WT, int item, LAS float* scr, int lane) {
    const int nblk = N / 32, kb = item / nblk, nb = item % nblk;
    transpose_item(W, K, N, WT, 64 * kb, 32 * nb, 32 * nb, scr, lane);
}
struct ThinCtx { Prm p; LAS unsigned char* lds; int gw, ngw, lane, wave; };

__device__ __forceinline__ void thin_prolog_w(const ThinCtx& t) {
    const Prm& p = t.p; LAS float* scr = (LAS float*)(t.lds + t.wave * 16384);
    constexpr int I_ABIN = (DM / 64) * (ABIN / 32), I_ABOUT = (DM / 64) * (DM / 32), I_SIN = (DM / 64) * (SSD_IN / 32), I_SOUT = (SSD_DI / 64) * (DM / 32);
    constexpr int NIT = NEVEN * (I_ABIN + I_ABOUT) + NODD * (I_SIN + I_SOUT);
    for (int it = t.gw; it < NIT; it += t.ngw) {
        int r = it;
        if (r < NEVEN * I_ABIN) { const int l = r / I_ABIN; transpose_plain(p.in[I_ABWIN] + (size_t)l * DM * ABIN, DM, ABIN, WSP(bf16_t, WS_WABIN) + (size_t)l * ABIN * DM, r % I_ABIN, scr, t.lane); continue; } r -= NEVEN * I_ABIN;
        if (r < NEVEN * I_ABOUT) { const int l = r / I_ABOUT; transpose_plain(p.in[I_ABWOUT] + (size_t)l * DM * DM, DM, DM, WSP(bf16_t, WS_WABOUT) + (size_t)l * DM * DM, r % I_ABOUT, scr, t.lane); continue; } r -= NEVEN * I_ABOUT;
        if (r < NODD * I_SIN) { const int l = r / I_SIN; transpose_plain(p.in[I_SSDWIN] + (size_t)l * DM * SSD_IN, DM, SSD_IN, WSP(bf16_t, WS_WSIN) + (size_t)l * SSD_NP * DM, r % I_SIN, scr, t.lane); continue; } r -= NODD * I_SIN;
        { const int l = r / I_SOUT; transpose_plain(p.in[I_SSDWOUT] + (size_t)l * SSD_DI * DM, SSD_DI, DM, WSP(bf16_t, WS_WSOUT) + (size_t)l * DM * SSD_DI, r % I_SOUT, scr, t.lane); }
    }
    constexpr int PADV = (SSD_NP - SSD_IN) * DM / 8;
    for (int i = t.gw * 64 + t.lane; i < NODD * PADV; i += t.ngw * 64) { const int l = i / PADV, j = i % PADV;
        *(u32x4_t*)(WSP(bf16_t, WS_WSIN) + ((size_t)l * SSD_NP + SSD_IN) * DM + (size_t)j * 8) = (u32x4_t){0u, 0u, 0u, 0u}; }
}
__device__ __forceinline__ void thin_moe_w(const ThinCtx& t, int layer) {
    const Prm& p = t.p; LAS float* scr = (LAS float*)(t.lds + t.wave * 16384);
    constexpr int I_G = (DM / 64) * (MOE_HID / 32), I_D = (MOE_HID / 64) * (DM / 32), PER_E = 2 * I_G + I_D;
    for (int it = t.gw; it < MOE_E * PER_E; it += t.ngw) {
        const int e = it / PER_E; int r = it % PER_E;
        bf16_t* w1 = WSP(bf16_t, WS_W1) + (size_t)e * 2 * MOE_HID * DM;
        if (r < 2 * I_G) { const int isup = r / I_G; r %= I_G; const int nblk = MOE_HID / 32, kb = r / nblk, nb = r % nblk, n0 = 32 * nb;
            const float* src = (isup ? p.in[I_MWUP] : p.in[I_MWGATE]) + (size_t)(layer * MOE_E + e) * DM * MOE_HID;
            transpose_item(src, DM, MOE_HID, w1, 64 * kb, n0, (n0 / MOE_HB) * 2 * MOE_HB + isup * MOE_HB + (n0 % MOE_HB), scr, t.lane); continue; }
        r -= 2 * I_G;
        transpose_plain(p.in[I_MWDOWN] + (size_t)(layer * MOE_E + e) * MOE_HID * DM, MOE_HID, DM, WSP(bf16_t, WS_W2) + (size_t)e * DM * MOE_HID, r, scr, t.lane);
    }
}


__device__ __forceinline__ void thin_mods(const ThinCtx& t) {
    const Prm& p = t.p; const int lane = t.lane, wave = t.wave, tid = wave * 64 + lane;
    constexpr int CB = 6 * DM / 128;
    LAS float* sl = (LAS float*)t.lds;
    LAS float* red = sl + (NB + 1) * DM;
    __syncthreads();
    for (int i = tid; i < (NB + 1) * DM; i += NTHR) { const int j = i / DM, k = i % DM; const float v = j < NB ? p.in[I_C][j * DM + k] : p.in[I_CCTX][k]; sl[i] = v / (1.f + expf(-v)); }
    __syncthreads();
    for (int cb = blockIdx.x; cb < DEPTH * CB; cb += gridDim.x) {
        const int l = cb / CB, n0 = (cb % CB) * 128 + 2 * lane;
        const float* w = p.in[I_ADAW] + (size_t)l * DM * 6 * DM + n0;
        float acc[NB + 1][2];
#pragma unroll
        for (int j = 0; j <= NB; ++j) { acc[j][0] = 0.f; acc[j][1] = 0.f; }
        const int k0 = wave * (DM / 8);
#pragma unroll 8
        for (int k = k0; k < k0 + DM / 8; ++k) { const f32x2_t wv = *(const f32x2_t*)(w + (size_t)k * 6 * DM);
#pragma unroll
            for (int j = 0; j <= NB; ++j) { const float s = sl[j * DM + k]; acc[j][0] += s * wv.x; acc[j][1] += s * wv.y; } }
#pragma unroll
        for (int j = 0; j <= NB; ++j) *(LAS f32x2_t*)(red + (wave * (NB + 1) + j) * 128 + 2 * lane) = (f32x2_t){acc[j][0], acc[j][1]};
        __syncthreads();
        for (int i = tid; i < (NB + 1) * 128; i += NTHR) { const int j = i / 128, cn = i % 128; float s = p.in[I_ADAB][(size_t)l * 6 * DM + (cb % CB) * 128 + cn];
#pragma unroll
            for (int wv = 0; wv < 8; ++wv) s += red[(wv * (NB + 1) + j) * 128 + cn];
            WSP(float, WS_MODS)[((size_t)(l * (NB + 1) + j)) * 6 * DM + (cb % CB) * 128 + cn] = s; }
        __syncthreads();
    }
}
constexpr int NRN = 4;
template <int MODE> __device__ __forceinline__ void thin_resnorm(const ThinCtx& t, int layer) {
    const Prm& p = t.p; const int lane = t.lane;
    LAS int* offs = (LAS int*)(t.lds + MISC_OFF + 128);
    if constexpr (MODE != 0) {
        __syncthreads();
        if (threadIdx.x < 64) { const int l = threadIdx.x; const int* cnt = WSP(const int, WS_CNT) + (layer - 1) * MOE_E; const int tl = l < MOE_E ? (cnt[l] + MOE_MT - 1) / MOE_MT * MOE_MT : 0; int v = tl;
#pragma unroll
            for (int o = 1; o < 64; o <<= 1) { const int tq = __shfl_up(v, o); if (l >= o) v += tq; }
            if (l < MOE_E) offs[l] = v - tl; }
        __syncthreads();
    }
    for (int r0 = t.gw * NRN; r0 < R; r0 += t.ngw * NRN) {
        const int b = r0 / TPB, tt = r0 % TPB; const int j = tt < CTX ? NB : b;
        if (MODE == 2 && tt < CTX) continue;
        f32x4_t xv[NRN][4];
        if constexpr (MODE == 0) {
#pragma unroll
            for (int q = 0; q < NRN; ++q) { const float* src = tt < CTX ? p.in[I_CTX] + ((size_t)b * CTX + tt + q) * DM : p.in[I_X] + ((size_t)b * SEQ + (tt + q - CTX)) * DM;
#pragma unroll
                for (int c = 0; c < 4; ++c) xv[q][c] = *(const f32x4_t*)(src + c * 256 + lane * 4); }
        } else {
            float w0[NRN], w1[NRN]; int s0[NRN], s1[NRN];
#pragma unroll
            for (int q = 0; q < NRN; ++q) { const int* ro = WSP(const int, WS_ROUTE) + (size_t)(r0 + q) * 8; w0[q] = __int_as_float(ro[4]); w1[q] = __int_as_float(ro[5]); s0[q] = offs[ro[0]] + ro[2]; s1[q] = offs[ro[1]] + ro[3]; }
            const float* gate = mod_ptr(p, layer - 1, j, 5);
            f32x4_t gv[4]; u32x2_t ya[NRN][4], yb[NRN][4];
#pragma unroll
            for (int c = 0; c < 4; ++c) gv[c] = *(const f32x4_t*)(gate + c * 256 + lane * 4);
#pragma unroll
            for (int q = 0; q < NRN; ++q) { const bf16_t* xr = WSP(const bf16_t, WS_X) + (size_t)(r0 + q) * DM;
                const bf16_t* y0 = WSP(const bf16_t, WS_YB) + (size_t)s0[q] * DM; const bf16_t* y1 = WSP(const bf16_t, WS_YB) + (size_t)s1[q] * DM;
#pragma unroll
                for (int c = 0; c < 4; ++c) { const int col = c * 256 + lane * 4; const u32x2_t xb = *(const u32x2_t*)(xr + col); xv[q][c] = (f32x4_t){bflo(xb.x), bfhi(xb.x), bflo(xb.y), bfhi(xb.y)};
                    ya[q][c] = *(const u32x2_t*)(y0 + col); yb[q][c] = *(const u32x2_t*)(y1 + col); } }
#pragma unroll
            for (int q = 0; q < NRN; ++q)
#pragma unroll
                for (int c = 0; c < 4; ++c) { const u32x2_t a = ya[q][c], bq = yb[q][c];
                    f32x4_t m; m.x = w0[q] * bflo(a.x) + w1[q] * bflo(bq.x); m.y = w0[q] * bfhi(a.x) + w1[q] * bfhi(bq.x); m.z = w0[q] * bflo(a.y) + w1[q] * bflo(bq.y); m.w = w0[q] * bfhi(a.y) + w1[q] * bfhi(bq.y);
                    xv[q][c] = xv[q][c] + gv[c] * m; }
        }
        if constexpr (MODE != 2) {
#pragma unroll
            for (int q = 0; q < NRN; ++q)
#pragma unroll
                for (int c = 0; c < 4; ++c) { u32x2_t o; o.x = pk2(xv[q][c].x, xv[q][c].y); o.y = pk2(xv[q][c].z, xv[q][c].w); *(u32x2_t*)(WSP(bf16_t, WS_X) + (size_t)(r0 + q) * DM + c * 256 + lane * 4) = o;
                    xv[q][c] = (f32x4_t){bflo(o.x), bfhi(o.x), bflo(o.y), bfhi(o.y)}; }
        }
        float rs[NRN];
#pragma unroll
        for (int q = 0; q < NRN; ++q) { float ss = 0.f;
#pragma unroll
            for (int c = 0; c < 4; ++c) ss += (xv[q][c].x * xv[q][c].x + xv[q][c].y * xv[q][c].y) + (xv[q][c].z * xv[q][c].z + xv[q][c].w * xv[q][c].w);
            rs[q] = ss; }
#pragma unroll
        for (int o = 1; o < 64; o <<= 1) {
#pragma unroll
            for (int q = 0; q < NRN; ++q) rs[q] += __shfl_xor(rs[q], o); }
#pragma unroll
        for (int q = 0; q < NRN; ++q) rs[q] = 1.f / sqrtf(rs[q] * (1.f / DM) + 1e-6f);
        if constexpr (MODE == 2) {
#pragma unroll
            for (int c = 0; c < 4; ++c) { const int col = c * 256 + lane * 4; const f32x4_t g = *(const f32x4_t*)(p.in[I_FNG] + col);
#pragma unroll
                for (int q = 0; q < NRN; ++q) *(f32x4_t*)(p.out + ((size_t)b * SEQ + (tt + q - CTX)) * DM + col) = xv[q][c] * rs[q] * g; }
        } else {
            const float* sh = mod_ptr(p, layer, j, 0); const float* sc = mod_ptr(p, layer, j, 1); const float* g1 = p.in[I_N1G] + (size_t)layer * DM;
#pragma unroll
            for (int c = 0; c < 4; ++c) { const int col = c * 256 + lane * 4;
                const f32x4_t g = *(const f32x4_t*)(g1 + col), s1v = *(const f32x4_t*)(sc + col), s0v = *(const f32x4_t*)(sh + col);
                const f32x4_t gs = g * (s1v + 1.f);
#pragma unroll
                for (int q = 0; q < NRN; ++q) { const f32x4_t v = xv[q][c] * rs[q] * gs + s0v;
                    u32x2_t o; o.x = pk2(v.x, v.y); o.y = pk2(v.z, v.w); *(u32x2_t*)(WSP(bf16_t, WS_H) + (size_t)(r0 + q) * DM + col) = o; } }
        }
    }
}

constexpr int RW = 4;
__device__ __forceinline__ void thin_n2rt(const ThinCtx& t, int layer, bool dry = false, bool skip_ctx = false) {
    typedef short bf16x8_t __attribute__((ext_vector_type(8)));
    const Prm& p = t.p; const int lane = t.lane, wave = t.wave, tid = wave * 64 + lane;
    const float* g2 = p.in[I_N2G] + (size_t)layer * DM;
    LAS float* hs = (LAS float*)t.lds;
    LAS float* part = (LAS float*)(t.lds + 65536);
    LAS float* les = (LAS float*)(t.lds + MISC_OFF + 512);
    LAS int* lcnt = (LAS int*)(t.lds + MISC_OFF + 9216);
    __syncthreads();
    if (threadIdx.x < 2 * MOE_E) lcnt[threadIdx.x] = 0;
    __syncthreads();
    const int arow = lane & 15, kq = lane >> 4;
    bf16x8_t bh[4][3], bl[4][3];
    { const bf16_t* wh = WSP(const bf16_t, WS_WET) + ((size_t)(layer * 2 + 0) * WET_ROWS + arow) * DM + 128 * wave + 8 * kq; const bf16_t* wl = wh + (size_t)WET_ROWS * DM;
#pragma unroll
      for (int ks = 0; ks < 4; ++ks)
#pragma unroll
        for (int nt = 0; nt < 3; ++nt) { bh[ks][nt] = *(const bf16x8_t*)(wh + 16 * nt * DM + 32 * ks); bl[ks][nt] = *(const bf16x8_t*)(wl + 16 * nt * DM + 32 * ks); } }
    u32x2_t xn[2][4];
#define N2RT_LOAD(bi_) do { if ((bi_) < R / 16 && !(skip_ctx && ((bi_) * 16) % TPB < CTX)) { _Pragma("unroll") for (int q = 0; q < 2; ++q) _Pragma("unroll") for (int c = 0; c < 4; ++c) \
        xn[q][c] = *(const u32x2_t*)(WSP(const bf16_t, WS_X) + (size_t)((bi_) * 16 + 2 * wave + q) * DM + c * 256 + lane * 4); } } while (0)
    N2RT_LOAD((int)blockIdx.x);
    for (int bi = blockIdx.x; bi < R / 16; bi += gridDim.x) {
        const int r0 = bi * 16, b = r0 / TPB, tt = r0 % TPB; const int j = tt < CTX ? NB : b;
        if (skip_ctx && tt < CTX) { N2RT_LOAD(bi + (int)gridDim.x); continue; }
        {
            const float* sh = mod_ptr(p, layer, j, 3); const float* sc = mod_ptr(p, layer, j, 4);
            f32x4_t xv[2][4], gm[4], s0m[4]; float rs[2];
#pragma unroll
            for (int q = 0; q < 2; ++q)
#pragma unroll
                for (int c = 0; c < 4; ++c) { const u32x2_t xb = xn[q][c]; xv[q][c] = (f32x4_t){bflo(xb.x), bfhi(xb.x), bflo(xb.y), bfhi(xb.y)}; }
            N2RT_LOAD(bi + (int)gridDim.x);
#pragma unroll
            for (int c = 0; c < 4; ++c) { const int col = c * 256 + lane * 4; gm[c] = *(const f32x4_t*)(g2 + col) * (*(const f32x4_t*)(sc + col) + 1.f); s0m[c] = *(const f32x4_t*)(sh + col); }
#pragma unroll
            for (int q = 0; q < 2; ++q) { float ss = 0.f;
#pragma unroll
                for (int c = 0; c < 4; ++c) ss += (xv[q][c].x * xv[q][c].x + xv[q][c].y * xv[q][c].y) + (xv[q][c].z * xv[q][c].z + xv[q][c].w * xv[q][c].w);
                rs[q] = ss; }
#pragma unroll
            for (int o = 1; o < 64; o <<= 1) {
#pragma unroll
                for (int q = 0; q < 2; ++q) rs[q] += __shfl_xor(rs[q], o); }
#pragma unroll
            for (int q = 0; q < 2; ++q) { const float rq = 1.f / sqrtf(rs[q] * (1.f / DM) + 1e-6f);
#pragma unroll
                for (int c = 0; c < 4; ++c) { const int col = c * 256 + lane * 4;
                    const f32x4_t hv = xv[q][c] * rq * gm[c] + s0m[c];
                    u32x2_t o; o.x = pk2(hv.x, hv.y); o.y = pk2(hv.z, hv.w); *(u32x2_t*)(WSP(bf16_t, WS_H) + (size_t)(r0 + 2 * wave + q) * DM + col) = o;
                    *(LAS f32x4_t*)(hs + (2 * wave + q) * DM + col) = hv; } }
        }
        __syncthreads();
        {
            const LAS float* ar = hs + arow * DM + 128 * wave + 8 * kq;
            f32x4_t acc0 = {0.f, 0.f, 0.f, 0.f}, acc1 = {0.f, 0.f, 0.f, 0.f}, acc2 = {0.f, 0.f, 0.f, 0.f};
#pragma unroll
            for (int ks = 0; ks < 4; ++ks) {
                const f32x4_t a0 = *(const LAS f32x4_t*)(ar + 32 * ks), a1 = *(const LAS f32x4_t*)(ar + 32 * ks + 4);
                u32x4_t hu; hu.x = pk2(a0.x, a0.y); hu.y = pk2(a0.z, a0.w); hu.z = pk2(a1.x, a1.y); hu.w = pk2(a1.z, a1.w);
                u32x4_t lu; lu.x = pk2(a0.x - bflo(hu.x), a0.y - bfhi(hu.x)); lu.y = pk2(a0.z - bflo(hu.y), a0.w - bfhi(hu.y)); lu.z = pk2(a1.x - bflo(hu.z), a1.y - bfhi(hu.z)); lu.w = pk2(a1.z - bflo(hu.w), a1.w - bfhi(hu.w));
                const bf16x8_t ah = *reinterpret_cast<bf16x8_t*>(&hu), al = *reinterpret_cast<bf16x8_t*>(&lu);
                acc0 = __builtin_amdgcn_mfma_f32_16x16x32_bf16(ah, bh[ks][0], acc0, 0, 0, 0); acc0 = __builtin_amdgcn_mfma_f32_16x16x32_bf16(ah, bl[ks][0], acc0, 0, 0, 0); acc0 = __builtin_amdgcn_mfma_f32_16x16x32_bf16(al, bh[ks][0], acc0, 0, 0, 0);
                acc1 = __builtin_amdgcn_mfma_f32_16x16x32_bf16(ah, bh[ks][1], acc1, 0, 0, 0); acc1 = __builtin_amdgcn_mfma_f32_16x16x32_bf16(ah, bl[ks][1], acc1, 0, 0, 0); acc1 = __builtin_amdgcn_mfma_f32_16x16x32_bf16(al, bh[ks][1], acc1, 0, 0, 0);
                acc2 = __builtin_amdgcn_mfma_f32_16x16x32_bf16(ah, bh[ks][2], acc2, 0, 0, 0); acc2 = __builtin_amdgcn_mfma_f32_16x16x32_bf16(ah, bl[ks][2], acc2, 0, 0, 0); acc2 = __builtin_amdgcn_mfma_f32_16x16x32_bf16(al, bh[ks][2], acc2, 0, 0, 0);
            }
#pragma unroll
            for (int r = 0; r < 4; ++r) { LAS float* pr = part + (wave * 16 + 4 * kq + r) * WET_ROWS; pr[arow] = acc0[r]; pr[16 + arow] = acc1[r]; pr[32 + arow] = acc2[r]; }
        }
        __syncthreads();
        for (int o = tid; o < 16 * (MOE_E + MOE_G); o += NTHR) { const int row = o / (MOE_E + MOE_G), e = o % (MOE_E + MOE_G);
            float s = e < MOE_E ? p.in[I_MBE][layer * MOE_E + e] : p.in[I_MBG][layer * MOE_G + (e - MOE_E)];
#pragma unroll
            for (int w = 0; w < 8; ++w) s += part[(w * 16 + row) * WET_ROWS + e];
            les[row * WET_ROWS + e] = s; }
        __syncthreads();
        if (tid < 16 && !dry) {
            const int q = tid;
            float lg[MOE_G];
#pragma unroll
            for (int i = 0; i < MOE_G; ++i) lg[i] = les[q * WET_ROWS + MOE_E + i];
            int gi = 0; float gm = lg[0];
#pragma unroll
            for (int i = 1; i < MOE_G; ++i) if (lg[i] > gm) { gm = lg[i]; gi = i; }
            float gs = 0.f;
#pragma unroll
            for (int i = 0; i < MOE_G; ++i) gs += expf(lg[i] - gm);
            const float g_w = 1.f / gs;
            float el[MOE_EPG];
#pragma unroll
            for (int i = 0; i < MOE_EPG; ++i) el[i] = les[q * WET_ROWS + gi * MOE_EPG + i];
            int i0 = 0; float m0 = el[0];
#pragma unroll
            for (int i = 1; i < MOE_EPG; ++i) if (el[i] > m0) { m0 = el[i]; i0 = i; }
            int i1 = -1; float m1 = -3.4e38f;
#pragma unroll
            for (int i = 0; i < MOE_EPG; ++i) if (i != i0 && el[i] > m1) { m1 = el[i]; i1 = i; }
            const float p1 = expf(m1 - m0);
            const float w0 = g_w / (1.f + p1), w1 = g_w * p1 / (1.f + p1);
            const int e0 = gi * MOE_EPG + i0, e1 = gi * MOE_EPG + i1;
            const int k0 = atomicAdd((int*)&lcnt[e0], 1), k1 = atomicAdd((int*)&lcnt[e1], 1);
            int* ro = WSP(int, WS_ROUTE) + (size_t)(r0 + q) * 8;
            ro[0] = e0; ro[1] = e1; ro[2] = k0; ro[3] = k1; ro[4] = __float_as_int(w0); ro[5] = __float_as_int(w1);
        }
    }
#undef N2RT_LOAD
    asm volatile("s_waitcnt vmcnt(0) lgkmcnt(0)" ::: "memory");
    __syncthreads();
    if (!dry && threadIdx.x < MOE_E) { const int n = lcnt[threadIdx.x]; lcnt[MOE_E + threadIdx.x] = n ? atomicAdd(WSP(int, WS_CNT) + layer * MOE_E + threadIdx.x, n) : 0; }
    __syncthreads();
    if (!dry && tid < 16) for (int bi0 = blockIdx.x; bi0 < R / 16; bi0 += 4 * gridDim.x) {
        int e0[4], e1[4], k0[4], k1[4]; bool ok[4];
#pragma unroll
        for (int i = 0; i < 4; ++i) { const int bi = bi0 + i * (int)gridDim.x, r = bi * 16 + tid; ok[i] = bi < R / 16 && !(skip_ctx && r % TPB < CTX);
            if (ok[i]) { const int* ro = WSP(const int, WS_ROUTE) + (size_t)r * 8; e0[i] = ro[0]; e1[i] = ro[1]; k0[i] = ro[2]; k1[i] = ro[3]; } }
#pragma unroll
        for (int i = 0; i < 4; ++i) if (ok[i]) { const int r = (bi0 + i * (int)gridDim.x) * 16 + tid; int* ro = WSP(int, WS_ROUTE) + (size_t)r * 8;
            const int a0 = k0[i] + lcnt[MOE_E + e0[i]], a1 = k1[i] + lcnt[MOE_E + e1[i]];
            ro[2] = a0; ro[3] = a1; WSP(int, WS_LIST)[(size_t)e0[i] * CAPL + a0] = r; WSP(int, WS_LIST)[(size_t)e1[i] * CAPL + a1] = r; }
    }
}
__device__ __forceinline__ void thin_gather(const ThinCtx& t, int layer) {
    const Prm& p = t.p; const int lane = t.lane;
    LAS int* offs = (LAS int*)(t.lds + MISC_OFF + 128);
    __syncthreads();
    if (threadIdx.x < 64) { const int l = threadIdx.x; const int* cnt = WSP(const int, WS_CNT) + layer * MOE_E; const int tl = l < MOE_E ? (cnt[l] + MOE_MT - 1) / MOE_MT * MOE_MT : 0; int v = tl;
#pragma unroll
        for (int o = 1; o < 64; o <<= 1) { const int tq = __shfl_up(v, o); if (l >= o) v += tq; }
        if (l < MOE_E) offs[l] = v - tl; }
    __syncthreads();
    for (int r0 = t.gw * 2; r0 < R; r0 += t.ngw * 2) {
        int slot[2][2]; u32x4_t v[2][2];
#pragma unroll
        for (int q = 0; q < 2; ++q) { int* ro = WSP(int, WS_ROUTE) + (size_t)(r0 + q) * 8;
            const int e0 = ro[0], e1 = ro[1], k0 = ro[2], k1 = ro[3];
            slot[q][0] = offs[e0] + k0; slot[q][1] = offs[e1] + k1;
            const bf16_t* h = WSP(const bf16_t, WS_H) + (size_t)(r0 + q) * DM;
            v[q][0] = *(const u32x4_t*)(h + lane * 8); v[q][1] = *(const u32x4_t*)(h + 512 + lane * 8); }
#pragma unroll
        for (int q = 0; q < 2; ++q) { int* ro = WSP(int, WS_ROUTE) + (size_t)(r0 + q) * 8;
            if (lane == 0) { ro[6] = slot[q][0]; ro[7] = slot[q][1]; }
#pragma unroll
            for (int jj = 0; jj < 2; ++jj) { bf16_t* xb = WSP(bf16_t, WS_XB) + (size_t)slot[q][jj] * DM; *(u32x4_t*)(xb + lane * 8) = v[q][0]; *(u32x4_t*)(xb + 512 + lane * 8) = v[q][1]; } }
    }
}
__device__ __forceinline__ void thin_even_mid(const ThinCtx& t, int ih, bool do_rope) {
    const Prm& p = t.p; const int lane = t.lane;
    const float* tab = WSP(const float, WS_ROPE);
    const float* cw = p.in[I_BCONV] + (size_t)ih * 3 * CW;
    if (do_rope) {
        const int blk = lane >> 1, sub = lane & 1, axis = blk & 1;
        for (int r0 = t.gw * 4; r0 < R; r0 += t.ngw * 4) {
            const int tt = r0 % TPB; if (tt < CTX) continue;
            u32x4_t a1[4], a2[4]; f32x4_t tb[4][4];
#pragma unroll
            for (int q = 0; q < 4; ++q) { const int pos = tt + q - CTX; const int pv = axis == 0 ? pos / GRID_W : pos % GRID_W;
                const bf16_t* q1 = WSP(const bf16_t, WS_QKVC) + (size_t)(r0 + q) * ABIN + blk * 32 + sub * 8;
                a1[q] = *(const u32x4_t*)q1; a2[q] = *(const u32x4_t*)(q1 + 16);
                const float* tp = tab + ((size_t)pv * 16 + sub * 8) * 2;
#pragma unroll
                for (int i = 0; i < 4; ++i) tb[q][i] = *(const f32x4_t*)(tp + 4 * i); }
#pragma unroll
            for (int q = 0; q < 4; ++q) { float x1[8], x2[8], o1[8], o2[8]; unpack8f(a1[q], x1); unpack8f(a2[q], x2);
#pragma unroll
                for (int i = 0; i < 8; ++i) { const float cs = tb[q][i >> 1][(i & 1) * 2], sn = tb[q][i >> 1][(i & 1) * 2 + 1]; o1[i] = x1[i] * cs - x2[i] * sn; o2[i] = x2[i] * cs + x1[i] * sn; }
                bf16_t* q1 = WSP(bf16_t, WS_QKVC) + (size_t)(r0 + q) * ABIN + blk * 32 + sub * 8;
                *(u32x4_t*)q1 = pack8f(o1); *(u32x4_t*)(q1 + 16) = pack8f(o2); }
        }
    }
    {
        const int ch = lane * 8;
        float w0[8], w1[8], w2[8];
#pragma unroll
        for (int i = 0; i < 8; ++i) { w0[i] = cw[ch + i]; w1[i] = cw[CW + ch + i]; w2[i] = cw[2 * CW + ch + i]; }
        for (int r0 = t.gw * 8; r0 < R; r0 += t.ngw * 8) {
            const int tt = r0 % TPB; const bool first = (tt == 0) || (tt == CTX), last = (tt + 8 == CTX) || (tt + 8 == TPB);
            const bf16_t* row = WSP(const bf16_t, WS_QKVC) + (size_t)r0 * ABIN + 3 * DW + ch;
            u32x4_t gcv[10], xcv[10], gbv[8];
#pragma unroll
            for (int q = 0; q < 10; ++q) { const bool ok = !((q == 0 && first) || (q == 9 && last)); const bf16_t* rp = row + (long)(q - 1) * ABIN;
                gcv[q] = ok ? *(const u32x4_t*)(rp + CW) : (u32x4_t){0u, 0u, 0u, 0u}; xcv[q] = ok ? *(const u32x4_t*)(rp + 2 * CW) : (u32x4_t){0u, 0u, 0u, 0u}; }
#pragma unroll
            for (int q = 0; q < 8; ++q) gbv[q] = *(const u32x4_t*)(row + (long)q * ABIN);
            float u0[8], u1[8], u2[8], gc[8], xc[8];
            unpack8f(gcv[0], gc); unpack8f(xcv[0], xc);
#pragma unroll
            for (int i = 0; i < 8; ++i) u0[i] = gc[i] * xc[i];
            unpack8f(gcv[1], gc); unpack8f(xcv[1], xc);
#pragma unroll
            for (int i = 0; i < 8; ++i) u1[i] = gc[i] * xc[i];
#pragma unroll
            for (int q = 0; q < 8; ++q) { unpack8f(gcv[q + 2], gc); unpack8f(xcv[q + 2], xc);
                float gb[8], o[8]; unpack8f(gbv[q], gb);
#pragma unroll
                for (int i = 0; i < 8; ++i) { u2[i] = gc[i] * xc[i]; o[i] = gb[i] * (w0[i] * u0[i] + w1[i] * u1[i] + w2[i] * u2[i]); u0[i] = u1[i]; u1[i] = u2[i]; }
                *(u32x4_t*)(WSP(bf16_t, WS_CAT) + (size_t)(r0 + q) * DM + DW + ch) = pack8f(o); }
        }
    }
}
__device__ __forceinline__ void thin_combine(const ThinCtx& t, int ih) {
    const Prm& p = t.p; const int lane = t.lane;
    const float lam = WSP(const float, WS_LAM)[ih], li = lam_init_of(ih);
    const float* sg = p.in[I_SUBLN] + (size_t)ih * VD;
    for (int r = t.gw; r < R; r += t.ngw) {
        const int h = lane >> 4, d0 = (lane & 15) * 8;
        const float* o1 = WSP(const float, WS_O12) + ((size_t)r * 2 * NDH + 2 * h) * VD + d0; const float* o2 = o1 + VD;
        float v[8]; float ss = 0.f;
        const f32x4_t a0 = *(const f32x4_t*)o1, a1 = *(const f32x4_t*)(o1 + 4), b0 = *(const f32x4_t*)o2, b1 = *(const f32x4_t*)(o2 + 4);
#pragma unroll
        for (int i = 0; i < 4; ++i) { v[i] = a0[i] - lam * b0[i]; v[4 + i] = a1[i] - lam * b1[i]; }
#pragma unroll
        for (int i = 0; i < 8; ++i) ss += v[i] * v[i];
#pragma unroll
        for (int o = 1; o < 16; o <<= 1) ss += __shfl_xor(ss, o);
        const float rs = (1.f - li) / sqrtf(ss * (1.f / VD) + 1e-6f);
#pragma unroll
        for (int i = 0; i < 8; ++i) v[i] = v[i] * rs * sg[d0 + i];
        *(u32x4_t*)(WSP(bf16_t, WS_CAT) + (size_t)r * DM + h * VD + d0) = pack8f(v);
    }
}
__device__ __forceinline__ void thin_ssdconv(const ThinCtx& t, int ih) {
    const Prm& p = t.p; const int lane = t.lane;
    const float* w = p.in[I_SSDCW] + (size_t)ih * 3 * SSD_CC; const float* cb = p.in[I_SSDCB] + (size_t)ih * SSD_CC;
    constexpr int NG = SSD_CC / 512 + 1;
    for (int it = t.gw; it < (R / 16) * NG; it += t.ngw) {
        const int g = it % NG, r0 = (it / NG) * 16, tt = r0 % TPB;
        if (g == NG - 1) {
            const float bias = p.in[I_SSDDTB][(size_t)ih * 2 * SSD_H + lane]; bf16_t raw[16];
#pragma unroll
            for (int q = 0; q < 16; ++q) raw[q] = WSP(const bf16_t, WS_ZXD)[(size_t)(r0 + q) * SSD_NP + SSD_DI + SSD_CC + lane];
#pragma unroll
            for (int q = 0; q < 16; ++q) { const float v = bf2f(raw[q]) + bias; WSP(float, WS_DT)[(size_t)(r0 + q) * 2 * SSD_H + lane] = v > 20.f ? v : log1pf(expf(v)); }
            continue;
        }
        const bool first = (tt == 0) || (tt == CTX), last = (tt + 16 == CTX) || (tt + 16 == TPB);
        const int ch = g * 512 + lane * 8;
        const bf16_t* z = WSP(const bf16_t, WS_ZXD) + (size_t)r0 * SSD_NP + SSD_DI + ch;
        u32x4_t xin[18];
#pragma unroll
        for (int q = 0; q < 18; ++q) { const bool ok = !((q == 0 && first) || (q == 17 && last)); xin[q] = ok ? *(const u32x4_t*)(z + (long)(q - 1) * SSD_NP) : (u32x4_t){0u, 0u, 0u, 0u}; }
        float w0[8], w1[8], w2[8], bv[8];
#pragma unroll
        for (int i = 0; i < 8; ++i) { w0[i] = w[ch + i]; w1[i] = w[SSD_CC + ch + i]; w2[i] = w[2 * SSD_CC + ch + i]; bv[i] = cb[ch + i]; }
        float a[8], bq[8], c[8], o[8];
        unpack8f(xin[0], a); unpack8f(xin[1], bq);
#pragma unroll
        for (int q = 0; q < 16; ++q) { unpack8f(xin[q + 2], c);
#pragma unroll
            for (int i = 0; i < 8; ++i) { o[i] = silu_fast(w0[i] * a[i] + w1[i] * bq[i] + w2[i] * c[i] + bv[i]); a[i] = bq[i]; bq[i] = c[i]; }
            *(u32x4_t*)(WSP(bf16_t, WS_XBC) + (size_t)(r0 + q) * SSD_CC + ch) = pack8f(o); }
    }
}
__device__ __forceinline__ void thin_gnorm(const ThinCtx& t, int ih) {
    const Prm& p = t.p; const int lane = t.lane;
    const float* Dk = p.in[I_SSDD] + (size_t)ih * SSD_H; const float* ng = p.in[I_SSDNG] + (size_t)ih * SSD_DI;
    float dk[SSD_G];
#pragma unroll
    for (int g = 0; g < SSD_G; ++g) dk[g] = Dk[(g * 512 + lane * 8) / SSD_P];
    for (int r = t.gw; r < R; r += t.ngw) {
        u32x4_t yf[SSD_G], yb[SSD_G], xs[SSD_G], zz[SSD_G];
#pragma unroll
        for (int g = 0; g < SSD_G; ++g) { const int col = g * 512 + lane * 8;
            yf[g] = *(const u32x4_t*)(WSP(const bf16_t, WS_YS) + (size_t)r * SSD_DI + col); yb[g] = *(const u32x4_t*)(WSP(const bf16_t, WS_YS) + (size_t)(R + r) * SSD_DI + col);
            xs[g] = *(const u32x4_t*)(WSP(const bf16_t, WS_XBC) + (size_t)r * SSD_CC + col); zz[g] = *(const u32x4_t*)(WSP(const bf16_t, WS_ZXD) + (size_t)r * SSD_NP + col); }
        float v[SSD_G][8], ss[SSD_G];
#pragma unroll
        for (int g = 0; g < SSD_G; ++g) { float a[8], bq[8], c[8], d[8]; unpack8f(yf[g], a); unpack8f(yb[g], bq); unpack8f(xs[g], c); unpack8f(zz[g], d); float s = 0.f;
#pragma unroll
            for (int i = 0; i < 8; ++i) { v[g][i] = (a[i] + bq[i] + c[i] * dk[g]) * silu_fast(d[i]); s += v[g][i] * v[g][i]; }
            ss[g] = s; }
#pragma unroll
        for (int o = 1; o < 64; o <<= 1) {
#pragma unroll
            for (int g = 0; g < SSD_G; ++g) ss[g] += __shfl_xor(ss[g], o); }
#pragma unroll
        for (int g = 0; g < SSD_G; ++g) { const int col = g * 512 + lane * 8; const f32x4_t n0 = *(const f32x4_t*)(ng + col), n1 = *(const f32x4_t*)(ng + col + 4);
            const float rs = 1.f / sqrtf(ss[g] * (1.f / 512.f) + 1e-6f); float o[8];
#pragma unroll
            for (int i = 0; i < 8; ++i) o[i] = v[g][i] * rs * (i < 4 ? n0[i] : n1[i - 4]);
            *(u32x4_t*)(WSP(bf16_t, WS_YN) + (size_t)r * SSD_DI + col) = pack8f(o); }
    }
}
#ifndef DBL_MASK
#define DBL_MASK 0
#endif
#define DBL(x) ((DBL_MASK >> (x)) & 1)
#ifndef OPT_GEMM
#define OPT_GEMM 1
#endif
#ifndef OPT_ATTN
#define OPT_ATTN 1
#endif
#ifndef OPT_SSD
#define OPT_SSD 1
#endif
struct DevRunner {
    Prm p; XcdBarrier bar; LAS unsigned char* lds;
    template <int ST> __device__ __forceinline__ void naive(int layer) {
        Prm p = this->p; asm volatile("" : "+s"(p.ws)); p.ws = (unsigned char*)(__attribute__((address_space(1))) unsigned char*)p.ws;
        const size_t n = stage_items(ST);
        for (size_t i = (size_t)blockIdx.x * NTHR + threadIdx.x; i < n; i += (size_t)gridDim.x * NTHR) stage_item<ST>(p, layer, i);
    }
    __device__ __forceinline__ void moe_pref(int layer) {
        LAS int* pref = (LAS int*)(lds + MISC_OFF + 128);
        Prm p = this->p; asm volatile("" : "+s"(p.ws)); p.ws = (unsigned char*)(__attribute__((address_space(1))) unsigned char*)p.ws;
        __syncthreads();
        if (threadIdx.x < 64) { const int l = threadIdx.x; const int* cnt = WSP(const int, WS_CNT) + layer * MOE_E; const int tl = l < MOE_E ? (cnt[l] + MOE_MT - 1) / MOE_MT : 0; int v = tl;
#pragma unroll
            for (int o = 1; o < 64; o <<= 1) { const int tq = __shfl_up(v, o); if (l >= o) v += tq; }
            if (l < MOE_E) { pref[l] = v - tl; pref[MOE_E + 1 + l] = cnt[l]; } if (l == MOE_E - 1) pref[MOE_E] = v; }
        __syncthreads();
    }
    template <int ST> __device__ __forceinline__ void go(int layer) {
        const int ih = layer / 2; const int G = gridDim.x, c = blockIdx.x;
        Prm p = this->p; asm volatile("" : "+s"(p.ws)); p.ws = (unsigned char*)(__attribute__((address_space(1))) unsigned char*)p.ws;
        if constexpr (OPT_GEMM && ST == ST_G1E) {
            pg8::Gemm g{WSP(const bf16_t, WS_H), WSP(const bf16_t, WS_WABIN) + (size_t)ih * ABIN * DM, R, ABIN, DM}; pg8::StaticOrder S; S.init(R, ABIN, G, c);
            pg8::EpiStoreRope E{WSP(bf16_t, WS_QKVC), ABIN, WSP(const float, WS_ROPE), 2 * DW / 256}; pg8::gemm_phase<pg8::EpiStoreRope, pg8::StaticOrder, true, true>(lds, g, S, E);
        } else if constexpr (OPT_GEMM && ST == ST_G2E) {
            pg8::Gemm g{WSP(const bf16_t, WS_CAT), WSP(const bf16_t, WS_WABOUT) + (size_t)ih * DM * DM, R, DM, DM}; pg8::StaticOrder S; S.init(R, DM, G, c);
            pg8::EpiResid E{WSP(bf16_t, WS_X), WSP(const float, WS_MODS) + (size_t)layer * (NB + 1) * 6 * DM, 2, DM}; pg8::gemm_phase<pg8::EpiResid, pg8::StaticOrder, true, true>(lds, g, S, E);
        } else if constexpr (OPT_GEMM && ST == ST_G1O) {
            pg8::Gemm g{WSP(const bf16_t, WS_H), WSP(const bf16_t, WS_WSIN) + (size_t)ih * SSD_NP * DM, R, SSD_NP, DM}; pg8::StaticOrder S; S.init(R, SSD_NP, G, c);
            pg8::EpiStore E{WSP(bf16_t, WS_ZXD), SSD_NP}; pg8::gemm_phase<pg8::EpiStore, pg8::StaticOrder, true, true>(lds, g, S, E);
        } else if constexpr (OPT_GEMM && ST == ST_G2O) {
            pg8::Gemm g{WSP(const bf16_t, WS_YN), WSP(const bf16_t, WS_WSOUT) + (size_t)ih * DM * SSD_DI, R, DM, SSD_DI};
            pg8::EpiResid E{WSP(bf16_t, WS_X), WSP(const float, WS_MODS) + (size_t)layer * (NB + 1) * 6 * DM, 2, DM};
            if (layer == DEPTH - 1) { pg8::LatentOrder S{G, c, DM / 256}; pg8::gemm_phase<pg8::EpiResid, pg8::LatentOrder, true, true>(lds, g, S, E); }
            else { pg8::StaticOrder S; S.init(R, DM, G, c); pg8::gemm_phase<pg8::EpiResid, pg8::StaticOrder, true, true>(lds, g, S, E); }
        } else if constexpr (OPT_GEMM && ST == ST_MOE1) {
            moe_pref(layer);
            const LAS int* pref = (const LAS int*)(lds + MISC_OFF + 128);
            const int vcu = (G % 8 == 0) ? (c % 8) * (G / 8) + c / 8 : c;
            pg8::MoeOrder S{pref, G, vcu, 2 * MOE_HID / 256};
            LAS int* rowtok = (LAS int*)(lds + MISC_OFF + 9472);
            { int tix = threadIdx.x; asm volatile("" : "+v"(tix));
              int tk[4]; bool has[4];
#pragma unroll
              for (int i = 0; i < 4; ++i) { pg8::Unit u; has[i] = S.next(i, u); tk[i] = 0;
                  if (has[i] && tix < 256) { int e = 0;
#pragma unroll
                      for (int q = 1; q < MOE_E; ++q) e = (u.pm >= pref[q]) ? q : e;
                      const int lr = (u.pm - pref[e]) * 256 + tix;
                      if (lr < pref[MOE_E + 1 + e]) tk[i] = WSP(const int, WS_LIST)[(size_t)e * CAPL + lr]; } }
#pragma unroll
              for (int i = 0; i < 4; ++i) if (has[i] && tix < 256) rowtok[i * 256 + tix] = tk[i]; }
            __syncthreads();
            pg8::Gemm g{WSP(const bf16_t, WS_H), WSP(const bf16_t, WS_W1), NSLOT, 2 * MOE_HID, DM};
            pg8::EpiSwiGLU E{WSP(bf16_t, WS_ACT), MOE_HID}; pg8::gemm_phase<pg8::EpiSwiGLU, pg8::MoeOrder, true, true, true>(lds, g, S, E, rowtok);
        } else if constexpr (OPT_GEMM && ST == ST_MOE2) {
            moe_pref(layer);
            pg8::Gemm g{WSP(const bf16_t, WS_ACT), WSP(const bf16_t, WS_W2), NSLOT, DM, MOE_HID}; pg8::MoeOrder S{(const LAS int*)(lds + MISC_OFF + 128), G, (G % 8 == 0) ? (c % 8) * (G / 8) + c / 8 : c, DM / 256};
            pg8::EpiStore E{WSP(bf16_t, WS_YB), DM}; pg8::gemm_phase<pg8::EpiStore, pg8::MoeOrder, true, true>(lds, g, S, E);
        } else if constexpr (OPT_ATTN && ST == ST_ATTN) {
            const int vcu = (G % 8 == 0) ? (c % 8) * (G / 8) + c / 8 : c;
            constexpr int NQB = SEQ / 256, NLAT = NB * NDH * NQB, NUNIT = NLAT + NB * NDH;
#define ATT_DECODE(uu) int b_, h_, row0_, seq_; { int u2 = (uu); asm volatile("" : "+s"(u2)); if (u2 < NLAT) { const int qb = u2 % NQB; h_ = (u2 / NQB) % NDH; b_ = u2 / (NQB * NDH); row0_ = b_ * TPB + CTX + qb * 256; seq_ = TPB; } \
                else { const int v = u2 - NLAT; h_ = v % NDH; b_ = v / NDH; row0_ = b_ * TPB; seq_ = CTX; } }
            for (int u = vcu; u < NUNIT; u += G) {
#pragma unroll 1
                for (int cc = 0; cc < 2; ++cc) {
                    ATT_DECODE(u);
                    const bf16_t* Q = WSP(const bf16_t, WS_QKVC); float* O = WSP(float, WS_O12); const size_t kv0 = (size_t)b_ * TPB * ABIN;
                    __syncthreads();
                    att::attn_dense_body(Q + (size_t)row0_ * ABIN + h_ * VD + cc * QKD, Q + kv0 + DW + h_ * VD, Q + kv0 + 2 * DW + h_ * VD,
                                         O + (size_t)row0_ * att::LDO + (2 * h_ + cc) * VD, seq_, (char*)lds, cc * QKD * 2);
                }
                { ATT_DECODE(u); (void)seq_; (void)b_;
                  float* O = WSP(float, WS_O12);
                  att::attn_combine(O + (size_t)row0_ * att::LDO + 2 * h_ * VD, O + (size_t)row0_ * att::LDO + (2 * h_ + 1) * VD, WSP(const float, WS_LAM)[ih], 1.f - lam_init_of(ih),
                                    p.in[I_SUBLN] + (size_t)ih * VD, WSP(bf16_t, WS_CAT) + (size_t)row0_ * DM + h_ * VD, DM); }
            }
#undef ATT_DECODE
        } else if constexpr (OPT_SSD && ST == ST_SSD) {
            const int vcu = (G % 8 == 0) ? (c % 8) * (G / 8) + c / 8 : c;
            for (int u = vcu; u < NB * 2 * SSD_H; u += G) { __syncthreads(); ssd::ssd_unit(p, ih, u / (2 * SSD_H), (u / SSD_H) % 2, u % SSD_H, lds); }
        } else naive<ST>(layer);
    }
    __device__ __forceinline__ void sync() { xcd_barrier(bar); if (DBL(4)) xcd_barrier(bar); }
    __device__ __forceinline__ ThinCtx tc() const {
        ThinCtx t; t.p = this->p; asm volatile("" : "+s"(t.p.ws)); t.p.ws = (unsigned char*)(GAS unsigned char*)t.p.ws;
        int tid = threadIdx.x; asm volatile("" : "+v"(tid));
        t.lds = lds; t.wave = __builtin_amdgcn_readfirstlane(tid >> 6); t.lane = tid & 63; t.gw = blockIdx.x * (NTHR / 64) + t.wave; t.ngw = gridDim.x * (NTHR / 64); return t;
    }
};
template <int layer> __device__ __forceinline__ void mk_layer(DevRunner& run) {
    constexpr int ih = layer / 2;
    if constexpr (layer > 0) { thin_moe_w(run.tc(), layer); if (DBL(5)) thin_moe_w(run.tc(), layer); thin_resnorm<1>(run.tc(), layer); run.sync(); }
    if constexpr (layer % 2 == 0) {
        run.template go<ST_G1E>(layer); if (DBL(2)) run.template go<ST_G1E>(layer); run.sync();
        {
            ThinCtx t = run.tc(); const int G_ = (int)gridDim.x, c_ = (int)blockIdx.x, vcu_ = (G_ % 8 == 0) ? (c_ % 8) * (G_ / 8) + c_ / 8 : c_;
            if (G_ > 2 * NB * NDH) { t.gw = (vcu_ - NB * NDH) * (NTHR / 64) + t.wave; t.ngw = (G_ - NB * NDH) * (NTHR / 64); if (vcu_ >= NB * NDH) thin_even_mid(t, ih, false); }
            else thin_even_mid(t, ih, false);
            if (DBL(6)) thin_even_mid(run.tc(), ih, false);
        }
        run.template go<ST_ATTN>(layer); if (DBL(0)) run.template go<ST_ATTN>(layer); run.sync();
        run.template go<ST_G2E>(layer); run.sync();
    } else {
        run.template go<ST_G1O>(layer); if (DBL(2)) run.template go<ST_G1O>(layer); run.sync();
        thin_ssdconv(run.tc(), ih); if (DBL(6)) thin_ssdconv(run.tc(), ih); run.sync();
        run.template go<ST_SSD>(layer); if (DBL(1)) run.template go<ST_SSD>(layer); run.sync();
        thin_gnorm(run.tc(), ih); if (DBL(6)) thin_gnorm(run.tc(), ih); run.sync();
        run.template go<ST_G2O>(layer); run.sync();
    }
    thin_n2rt(run.tc(), layer, false, layer == DEPTH - 1); run.sync();
    run.template go<ST_MOE1>(layer); if (DBL(3)) run.template go<ST_MOE1>(layer); run.sync();
    run.template go<ST_MOE2>(layer); if (DBL(3)) run.template go<ST_MOE2>(layer); run.sync();
}
__device__ __forceinline__ void mk_program(DevRunner& run) {
    thin_mods(run.tc()); thin_prolog_w(run.tc()); thin_moe_w(run.tc(), 0); run.template naive<ST_MISC>(0);
    if (DBL(5)) { thin_prolog_w(run.tc()); thin_moe_w(run.tc(), 0); }
    if (DBL(7)) { thin_mods(run.tc()); }
    run.sync();
    thin_resnorm<0>(run.tc(), 0); run.sync();
    mk_layer<0>(run); mk_layer<1>(run); mk_layer<2>(run); mk_layer<3>(run);
    thin_resnorm<2>(run.tc(), DEPTH);
}

__global__ void __launch_bounds__(NTHR, 2) mk_fwd(Prm p) {
    extern __shared__ __attribute__((aligned(16))) unsigned char lds[];
    for (int u = threadIdx.x; u < (LDS_BYTES - LDSCTL_OFF) / 4; u += NTHR) ((LAS unsigned*)((LAS unsigned char*)lds + LDSCTL_OFF))[u] = 0u;
    __syncthreads();
    DevRunner run; run.p = p; run.lds = (LAS unsigned char*)lds;
    run.bar = xcd_barrier_post((unsigned*)(p.ws + WS_CTL) + CW_BAR, (volatile LAS unsigned*)((LAS unsigned char*)lds + MISC_OFF) + 8);
    mk_program(run);
}

extern "C" void kernel_launch(void* const* d_in, const int* in_sizes, int n_in, void* d_out, int out_size, void* d_ws, size_t ws_size, hipStream_t stream) {
    static int grid = 0;
    if (grid == 0) {
        if (n_in != N_IN || ws_size < WS_END || out_size != NB * SEQ * DM) { fprintf(stderr, "kernel_launch: bad args n_in %d ws %zu need %zu out %d\n", n_in, ws_size, (size_t)WS_END, out_size); grid = -1; return; }
        int dev = 0, cus = 0, per_cu = 0;
        if (hipGetDevice(&dev) != hipSuccess || hipDeviceGetAttribute(&cus, hipDeviceAttributeMultiprocessorCount, dev) != hipSuccess) { grid = -1; return; }
        if (hipFuncSetAttribute((const void*)mk_fwd, hipFuncAttributeMaxDynamicSharedMemorySize, LDS_BYTES) != hipSuccess) { fprintf(stderr, "kernel_launch: hipFuncSetAttribute failed\n"); grid = -1; return; }
        if (hipOccupancyMaxActiveBlocksPerMultiprocessor(&per_cu, (const void*)mk_fwd, NTHR, LDS_BYTES) != hipSuccess || per_cu < 1) { fprintf(stderr, "kernel_launch: occupancy query says %d\n", per_cu); (void)hipGetLastError(); grid = -1; return; }
        grid = cus;
    }
    if (grid < 0) return;
    if (hipMemsetAsync((char*)d_ws + WS_CTL, 0, CTL_BYTES, stream) != hipSuccess) return;
    Prm p{};
    for (int i = 0; i < N_IN; ++i) p.in[i] = (const float*)d_in[i];
    p.out = (float*)d_out; p.ws = (unsigned char*)d_ws;
    hipLaunchKernelGGL(mk_fwd, dim3(grid), dim3(NTHR), LDS_BYTES, stream, p);
}
#endif

#if !defined(CPU_EMU) && defined(PROBE_PHASES)
#define PROBE_K(name, call) __global__ void __launch_bounds__(NTHR, 2) name(Prm p, int layer) { extern __shared__ __attribute__((aligned(16))) unsigned char lds[]; DevRunner run; run.p = p; run.lds = (LAS unsigned char*)lds; run.bar.bar = nullptr; run.bar.x = 0; run.bar.st = nullptr; call; }
PROBE_K(pk_prolog_w, thin_prolog_w(run.tc()))
PROBE_K(pk_moe_w, thin_moe_w(run.tc(), layer))
PROBE_K(pk_resnorm0, thin_resnorm<0>(run.tc(), layer))
PROBE_K(pk_resnorm1, thin_resnorm<1>(run.tc(), layer))
PROBE_K(pk_resnorm2, thin_resnorm<2>(run.tc(), layer))
PROBE_K(pk_n2rt, thin_n2rt(run.tc(), layer))
PROBE_K(pk_gather, thin_gather(run.tc(), layer))
PROBE_K(pk_even_mid, thin_even_mid(run.tc(), layer, true))
PROBE_K(pk_combine, thin_combine(run.tc(), layer))
PROBE_K(pk_ssdconv, thin_ssdconv(run.tc(), layer))
PROBE_K(pk_gnorm, thin_gnorm(run.tc(), layer))
PROBE_K(pk_g1e, run.template go<ST_G1E>(0))
PROBE_K(pk_g2e, run.template go<ST_G2E>(0))
PROBE_K(pk_moe1, run.template go<ST_MOE1>(0))
PROBE_K(pk_attn, run.template go<ST_ATTN>(0))
PROBE_K(pk_ssd_naive, run.template naive<ST_SSD>(1))
PROBE_K(pk_ssd, run.template go<ST_SSD>(1))
#endif
```

```cpp
#ifndef CPU_EMU
#include <hip/hip_runtime.h>
#include <cstdio>
#include <cstdint>
#include <cstddef>
#include <cstring>
#define HD __host__ __device__ __forceinline__
#else
#include <cstdio>
#include <cstdint>
#include <cmath>
#include <cstring>
#include <cstddef>
#define HD inline
#endif

#ifdef TINY
constexpr int DM = 64, NB = 2, SEQ = 128, DEPTH = 4, GRID_W = 8, CTX = 64;
constexpr int NDH = 2, QKD = 8;
constexpr int SSD_P = 16, SSD_G = 2, SSD_N = 16;
constexpr int MOE_G = 2, MOE_EPG = 4, MOE_HID = 32;
constexpr int MOE_MT = 16;
constexpr int MOE_HB = 32;
constexpr int SSD_NP = 336;
#else
constexpr int DM = 1024, NB = 4, SEQ = 4096, DEPTH = 4, GRID_W = 64, CTX = 256;
constexpr int NDH = 4, QKD = 64;
constexpr int SSD_P = 64, SSD_G = 4, SSD_N = 128;
constexpr int MOE_G = 4, MOE_EPG = 8, MOE_HID = 512;
constexpr int MOE_MT = 256;
constexpr int MOE_HB = 128;
constexpr int SSD_NP = 5376;
#endif
constexpr int VD = 2 * QKD;
constexpr int DW = NDH * VD;
constexpr int CW = DM - DW;
constexpr int ABIN = 3 * DW + 3 * CW;
constexpr int SSD_DI = 2 * DM;
constexpr int SSD_H = SSD_DI / SSD_P;
constexpr int SSD_CC = SSD_DI + 2 * SSD_G * SSD_N;
constexpr int SSD_IN = SSD_DI + SSD_CC + 2 * SSD_H;
constexpr int SSD_E = SSD_H / SSD_G;
constexpr int MOE_E = MOE_G * MOE_EPG;
constexpr int TPB = CTX + SEQ;
constexpr int R = NB * TPB;
constexpr int NEVEN = (DEPTH + 1) / 2, NODD = DEPTH / 2;
constexpr int MAXSLOT = 2 * R + MOE_E * (MOE_MT - 1);
constexpr int NSLOT = (MAXSLOT + MOE_MT - 1) / MOE_MT * MOE_MT;
static_assert(SSD_NP >= SSD_IN, "pad");

typedef unsigned short bf16_t;
HD unsigned f2bf_u(float f) { unsigned u; memcpy(&u, &f, 4); return (u + 0x7fffu + ((u >> 16) & 1u)) >> 16; }
HD bf16_t f2bf(float f) { return (bf16_t)f2bf_u(f); }
HD float bf2f(bf16_t h) { unsigned u = ((unsigned)h) << 16; float f; memcpy(&f, &u, 4); return f; }
HD float siluf(float x) { return x / (1.f + expf(-x)); }
HD float softplusf(float x) { return x > 20.f ? x : log1pf(expf(x)); }

enum { I_X, I_C, I_CTX, I_CCTX, I_ADAW, I_ADAB, I_N1G, I_N2G, I_ABWIN, I_ABWOUT, I_LQ1, I_LK1, I_LQ2, I_LK2, I_SUBLN, I_BCONV,
       I_SSDWIN, I_SSDCW, I_SSDCB, I_SSDALOG, I_SSDDTB, I_SSDD, I_SSDNG, I_SSDWOUT, I_MWG, I_MBG, I_MWE, I_MBE, I_MWGATE, I_MWUP, I_MWDOWN, I_FNG, N_IN };

constexpr size_t al256(size_t x) { return (x + 255) / 256 * 256; }
constexpr size_t WS_CTL   = 0;
constexpr size_t CTL_BYTES = 1u << 20;
constexpr size_t WS_CNT   = WS_CTL + CTL_BYTES;
constexpr size_t WS_LAM   = al256(WS_CNT + (size_t)DEPTH * MOE_E * 4);
constexpr size_t WS_ROPE  = al256(WS_LAM + NEVEN * 4);
constexpr int WET_ROWS = 48;
constexpr size_t WS_WET   = al256(WS_ROPE + (size_t)GRID_W * (QKD / 4) * 2 * 4);
constexpr size_t WS_MODS  = al256(WS_WET + (size_t)DEPTH * 2 * WET_ROWS * DM * 2);
constexpr size_t WS_ROUTE = al256(WS_MODS + (size_t)DEPTH * (NB + 1) * 6 * DM * 4);
constexpr size_t WS_X     = al256(WS_ROUTE + (size_t)R * 32);
constexpr size_t WS_H     = al256(WS_X + (size_t)R * DM * 4);
constexpr size_t WS_WABIN = al256(WS_H + (size_t)R * DM * 2);
constexpr size_t WS_WABOUT= al256(WS_WABIN + (size_t)NEVEN * ABIN * DM * 2);
constexpr size_t WS_WSIN  = al256(WS_WABOUT + (size_t)NEVEN * DM * DM * 2);
constexpr size_t WS_WSOUT = al256(WS_WSIN + (size_t)NODD * SSD_NP * DM * 2);
constexpr size_t WS_W1    = al256(WS_WSOUT + (size_t)NODD * DM * SSD_DI * 2);
constexpr size_t WS_W2    = al256(WS_W1 + (size_t)MOE_E * 2 * MOE_HID * DM * 2);
constexpr size_t WS_BIG   = al256(WS_W2 + (size_t)MOE_E * DM * MOE_HID * 2);
constexpr size_t WS_QKVC  = WS_BIG;
constexpr size_t WS_O12   = al256(WS_QKVC + (size_t)R * ABIN * 2);
constexpr size_t WS_CAT   = al256(WS_O12 + (size_t)R * 2 * NDH * VD * 4);
constexpr size_t WS_EVEN_END = al256(WS_CAT + (size_t)R * DM * 2);
constexpr size_t WS_ZXD   = WS_BIG;
constexpr size_t WS_XBC   = al256(WS_ZXD + (size_t)R * SSD_NP * 2);
constexpr size_t WS_DT    = al256(WS_XBC + (size_t)R * SSD_CC * 2);
constexpr size_t WS_YS    = al256(WS_DT + (size_t)R * 2 * SSD_H * 4);
constexpr size_t WS_YN    = al256(WS_YS + (size_t)2 * R * SSD_DI * 2);
constexpr size_t WS_ODD_END = al256(WS_YN + (size_t)R * SSD_DI * 2);
constexpr size_t WS_XB    = WS_BIG;
constexpr size_t WS_ACT   = al256(WS_XB + (size_t)NSLOT * DM * 2);
constexpr size_t WS_YB    = al256(WS_ACT + (size_t)NSLOT * MOE_HID * 2);
constexpr size_t WS_LIST  = al256(WS_YB + (size_t)NSLOT * DM * 2);
constexpr int CAPL = 2 * R;
constexpr size_t WS_MOE_END = al256(WS_LIST + (size_t)MOE_E * CAPL * 4);
constexpr size_t WS_END   = WS_ODD_END > WS_EVEN_END ? (WS_ODD_END > WS_MOE_END ? WS_ODD_END : WS_MOE_END) : (WS_EVEN_END > WS_MOE_END ? WS_EVEN_END : WS_MOE_END);
#ifndef TINY
static_assert(WS_END <= (size_t)1024 * 1024 * 1024, "workspace must fit 1 GiB");
#endif

struct Prm {
    const float* in[N_IN];
    float* out;
    unsigned char* ws;
};
#define WSP(T, off) ((T*)(p.ws + (off)))

#ifdef CPU_EMU
static inline int atomic_add_int(int* a, int v) { int o = *a; *a += v; return o; }
#else
__device__ __forceinline__ int atomic_add_int(int* a, int v) { return atomicAdd(a, v); }
#endif

HD int row_b(int r) { return r / TPB; }
HD int row_t(int r) { return r % TPB; }
HD int row_modj(int r) { return row_t(r) < CTX ? NB : row_b(r); }
HD const float* mod_ptr(const Prm& p, int layer, int j, int which) { return WSP(const float, WS_MODS) + ((size_t)(layer * (NB + 1) + j) * 6 + which) * DM; }

HD void st_wt_item(const float* src, int K, int N, bf16_t* dst, size_t idx) {
    const int n = (int)(idx / K), k = (int)(idx % K);
    dst[idx] = f2bf(src[(size_t)k * N + n]);
}
constexpr size_t N_WT_ABIN = (size_t)NEVEN * ABIN * DM, N_WT_ABOUT = (size_t)NEVEN * DM * DM, N_WT_SIN = (size_t)NODD * SSD_NP * DM, N_WT_SOUT = (size_t)NODD * DM * SSD_DI;
HD void st_prolog_w(const Prm& p, size_t idx) {
    if (idx < N_WT_ABIN) { const int l = (int)(idx / ((size_t)ABIN * DM)); const size_t j = idx % ((size_t)ABIN * DM);
        st_wt_item(p.in[I_ABWIN] + (size_t)l * DM * ABIN, DM, ABIN, WSP(bf16_t, WS_WABIN) + (size_t)l * ABIN * DM, j); return; }
    idx -= N_WT_ABIN;
    if (idx < N_WT_ABOUT) { const int l = (int)(idx / ((size_t)DM * DM)); const size_t j = idx % ((size_t)DM * DM);
        st_wt_item(p.in[I_ABWOUT] + (size_t)l * DM * DM, DM, DM, WSP(bf16_t, WS_WABOUT) + (size_t)l * DM * DM, j); return; }
    idx -= N_WT_ABOUT;
    if (idx < N_WT_SIN) { const int l = (int)(idx / ((size_t)SSD_NP * DM)); const size_t j = idx % ((size_t)SSD_NP * DM);
        const int n = (int)(j / DM), k = (int)(j % DM);
        WSP(bf16_t, WS_WSIN)[(size_t)l * SSD_NP * DM + j] = n < SSD_IN ? f2bf(p.in[I_SSDWIN][(size_t)l * DM * SSD_IN + (size_t)k * SSD_IN + n]) : (bf16_t)0; return; }
    idx -= N_WT_SIN;
    { const int l = (int)(idx / ((size_t)DM * SSD_DI)); const size_t j = idx % ((size_t)DM * SSD_DI);
        st_wt_item(p.in[I_SSDWOUT] + (size_t)l * SSD_DI * DM, SSD_DI, DM, WSP(bf16_t, WS_WSOUT) + (size_t)l * DM * SSD_DI, j); }
}
constexpr size_t N_PROLOG_W = N_WT_ABIN + N_WT_ABOUT + N_WT_SIN + N_WT_SOUT;

constexpr size_t N_W1 = (size_t)MOE_E * 2 * MOE_HID * DM, N_W2 = (size_t)MOE_E * DM * MOE_HID;
HD void st_moe_w(const Prm& p, int layer, size_t idx) {
    if (idx < N_W1) {
        const int e = (int)(idx / ((size_t)2 * MOE_HID * DM)); const size_t j = idx % ((size_t)2 * MOE_HID * DM);
        const int row = (int)(j / DM), k = (int)(j % DM), pn = row / (2 * MOE_HB), rr = row % (2 * MOE_HB), isup = rr / MOE_HB, col = pn * MOE_HB + rr % MOE_HB;
        const float* src = (isup ? p.in[I_MWUP] : p.in[I_MWGATE]) + ((size_t)(layer * MOE_E + e) * DM + k) * MOE_HID + col;
        WSP(bf16_t, WS_W1)[idx] = f2bf(*src); return; }
    idx -= N_W1;
    { const int e = (int)(idx / ((size_t)DM * MOE_HID)); const size_t j = idx % ((size_t)DM * MOE_HID);
      const int n = (int)(j / MOE_HID), k = (int)(j % MOE_HID);
      WSP(bf16_t, WS_W2)[idx] = f2bf(p.in[I_MWDOWN][((size_t)(layer * MOE_E + e) * MOE_HID + k) * DM + n]); }
}
constexpr size_t N_MOE_W = N_W1 + N_W2;

HD void st_mods(const Prm& p, size_t idx) {
    const int l = (int)(idx / (6 * DM)), n = (int)(idx % (6 * DM));
    float acc[NB + 1];
#pragma unroll
    for (int j = 0; j <= NB; ++j) acc[j] = 0.f;
    const float* w = p.in[I_ADAW] + (size_t)l * DM * 6 * DM + n;
    for (int k = 0; k < DM; ++k) { const float wv = w[(size_t)k * 6 * DM];
#pragma unroll
        for (int j = 0; j < NB; ++j) acc[j] += siluf(p.in[I_C][j * DM + k]) * wv;
        acc[NB] += siluf(p.in[I_CCTX][k]) * wv; }
    const float bv = p.in[I_ADAB][(size_t)l * 6 * DM + n];
#pragma unroll
    for (int j = 0; j <= NB; ++j) WSP(float, WS_MODS)[((size_t)(l * (NB + 1) + j)) * 6 * DM + n] = acc[j] + bv;
}
constexpr size_t N_MODS = (size_t)DEPTH * 6 * DM;

HD void st_xinit(const Prm& p, size_t idx) {
    const int r = (int)(idx / DM), d = (int)(idx % DM), b = row_b(r), t = row_t(r);
    WSP(float, WS_X)[idx] = t < CTX ? p.in[I_CTX][((size_t)b * CTX + t) * DM + d] : p.in[I_X][((size_t)b * SEQ + (t - CTX)) * DM + d];
}
HD float lam_init_of(int i) { return 0.8f - 0.6f * expf(-0.3f * (float)(2 * i)); }
HD void st_misc(const Prm& p, size_t idx) {
    if (idx < (size_t)DEPTH * MOE_E) { WSP(int, WS_CNT)[idx] = 0; return; }
    if (idx >= (size_t)DEPTH * MOE_E + NEVEN + (size_t)GRID_W * (QKD / 4)) { const size_t q = idx - ((size_t)DEPTH * MOE_E + NEVEN + (size_t)GRID_W * (QKD / 4));
        const int l = (int)(q / ((size_t)WET_ROWS * DM)), e = (int)((q / DM) % WET_ROWS), k = (int)(q % DM);
        const float v = e < MOE_E ? p.in[I_MWE][((size_t)l * DM + k) * MOE_E + e] : (e < MOE_E + MOE_G ? p.in[I_MWG][((size_t)l * DM + k) * MOE_G + (e - MOE_E)] : 0.f);
        const bf16_t hi = f2bf(v), lo = f2bf(v - bf2f(hi));
        WSP(bf16_t, WS_WET)[((size_t)(l * 2 + 0) * WET_ROWS + e) * DM + k] = hi; WSP(bf16_t, WS_WET)[((size_t)(l * 2 + 1) * WET_ROWS + e) * DM + k] = lo; return; }
    if (idx >= (size_t)DEPTH * MOE_E + NEVEN) { const int q = (int)(idx - (size_t)DEPTH * MOE_E - NEVEN), pv = q / (QKD / 4), fi = q % (QKD / 4);
        const float ang = (float)pv * powf(10000.f, -(float)(2 * fi) / (float)(QKD / 2));
        WSP(float, WS_ROPE)[2 * q] = cosf(ang); WSP(float, WS_ROPE)[2 * q + 1] = sinf(ang); return; }
    const int i = (int)(idx - (size_t)DEPTH * MOE_E);
    float s1 = 0.f, s2 = 0.f;
    for (int d = 0; d < QKD; ++d) { s1 += p.in[I_LQ1][i * QKD + d] * p.in[I_LK1][i * QKD + d]; s2 += p.in[I_LQ2][i * QKD + d] * p.in[I_LK2][i * QKD + d]; }
    WSP(float, WS_LAM)[i] = expf(s1) - expf(s2) + lam_init_of(i);
}
constexpr size_t N_MISC = (size_t)DEPTH * MOE_E + NEVEN + (size_t)GRID_W * (QKD / 4) + (size_t)DEPTH * WET_ROWS * DM;

HD void st_norm1(const Prm& p, int layer, size_t r) {
    const float* x = WSP(const float, WS_X) + r * DM;
    float ss = 0.f; for (int d = 0; d < DM; ++d) ss += x[d] * x[d];
    const float rs = 1.f / sqrtf(ss / DM + 1e-6f);
    const int j = row_modj((int)r); const float* sh = mod_ptr(p, layer, j, 0); const float* sc = mod_ptr(p, layer, j, 1); const float* g = p.in[I_N1G] + (size_t)layer * DM;
    bf16_t* h = WSP(bf16_t, WS_H) + r * DM;
    for (int d = 0; d < DM; ++d) h[d] = f2bf(x[d] * rs * g[d] * (1.f + sc[d]) + sh[d]);
}

struct U4 { unsigned x, y, z, w; };
HD void unpack8(const bf16_t* p, float (&f)[8]) {
    U4 u; memcpy(&u, p, 16);
    unsigned w[4] = {u.x, u.y, u.z, u.w};
#pragma unroll
    for (int i = 0; i < 4; ++i) { unsigned lo = w[i] << 16, hi = w[i] & 0xffff0000u; memcpy(&f[2 * i], &lo, 4); memcpy(&f[2 * i + 1], &hi, 4); }
}
HD void gemm_blk(const bf16_t* A, size_t lda, const bf16_t* Bt, size_t ldb, int K, float (&acc)[4][4]) {
#pragma unroll
    for (int i = 0; i < 4; ++i)
#pragma unroll
        for (int j = 0; j < 4; ++j) acc[i][j] = 0.f;
    for (int k = 0; k < K; k += 8) {
        float a[4][8], b[4][8];
#pragma unroll
        for (int i = 0; i < 4; ++i) unpack8(A + i * lda + k, a[i]);
#pragma unroll
        for (int j = 0; j < 4; ++j) unpack8(Bt + j * ldb + k, b[j]);
#pragma unroll
        for (int i = 0; i < 4; ++i)
#pragma unroll
            for (int j = 0; j < 4; ++j)
#pragma unroll
                for (int q = 0; q < 8; ++q) acc[i][j] += a[i][q] * b[j][q];
    }
}
HD void st_gemm_bf16(const bf16_t* A, int K, const bf16_t* Bt, int N, bf16_t* C, size_t idx) {
    const int nb = N / 4; const int r0 = (int)(idx / nb) * 4, n0 = (int)(idx % nb) * 4;
    float acc[4][4]; gemm_blk(A + (size_t)r0 * K, K, Bt + (size_t)n0 * K, K, K, acc);
#pragma unroll
    for (int i = 0; i < 4; ++i)
#pragma unroll
        for (int j = 0; j < 4; ++j) C[(size_t)(r0 + i) * N + n0 + j] = f2bf(acc[i][j]);
}
HD void st_gemm_res(const Prm& p, int layer, const bf16_t* A, int K, const bf16_t* Bt, size_t idx) {
    const int nb = DM / 4; const int r0 = (int)(idx / nb) * 4, n0 = (int)(idx % nb) * 4;
    float acc[4][4]; gemm_blk(A + (size_t)r0 * K, K, Bt + (size_t)n0 * K, K, K, acc);
#pragma unroll
    for (int i = 0; i < 4; ++i) { const float* gate = mod_ptr(p, layer, row_modj(r0 + i), 2);
#pragma unroll
        for (int j = 0; j < 4; ++j) WSP(float, WS_X)[(size_t)(r0 + i) * DM + n0 + j] += gate[n0 + j] * acc[i][j]; }
}

constexpr int ROPE_PAIRS = 2 * NDH * 2 * 2 * (QKD / 4);
HD void st_rope(const Prm& p, size_t idx) {
    const int r = (int)(idx / ROPE_PAIRS); int q = (int)(idx % ROPE_PAIRS);
    const int t = row_t(r); if (t < CTX) return;
    const int pos = t - CTX;
    const int i = q % (QKD / 4); q /= (QKD / 4); const int axis = q % 2; q /= 2; const int c = q % 2; q /= 2; const int h = q % NDH; q /= NDH; const int which = q;
    const int col = which * DW + h * VD + c * QKD + axis * (QKD / 2) + i;
    const float posv = axis == 0 ? (float)(pos / GRID_W) : (float)(pos % GRID_W);
    const float inv = powf(10000.f, -(float)(2 * i) / (float)(QKD / 2));
    const float ang = posv * inv, cs = cosf(ang), sn = sinf(ang);
    bf16_t* base = WSP(bf16_t, WS_QKVC) + (size_t)r * ABIN + col;
    const float x1 = bf2f(base[0]), x2 = bf2f(base[QKD / 4]);
    base[0] = f2bf(x1 * cs - x2 * sn); base[QKD / 4] = f2bf(x2 * cs + x1 * sn);
}
HD void st_bconv(const Prm& p, int i_even, size_t idx) {
    const int r = (int)(idx / CW), ch = (int)(idx % CW), t = row_t(r);
    const bool first = (t == 0) || (t == CTX), last = (t == CTX - 1) || (t == TPB - 1);
    const bf16_t* q = WSP(const bf16_t, WS_QKVC) + (size_t)r * ABIN;
    const float* w = p.in[I_BCONV] + (size_t)i_even * 3 * CW;
    float u0 = 0.f, u2 = 0.f;
    const float u1 = bf2f(q[3 * DW + CW + ch]) * bf2f(q[3 * DW + 2 * CW + ch]);
    if (!first) u0 = bf2f(q[-(long)ABIN + 3 * DW + CW + ch]) * bf2f(q[-(long)ABIN + 3 * DW + 2 * CW + ch]);
    if (!last)  u2 = bf2f(q[(long)ABIN + 3 * DW + CW + ch]) * bf2f(q[(long)ABIN + 3 * DW + 2 * CW + ch]);
    const float cv = w[ch] * u0 + w[CW + ch] * u1 + w[2 * CW + ch] * u2;
    WSP(bf16_t, WS_CAT)[(size_t)r * DM + DW + ch] = f2bf(bf2f(q[3 * DW + ch]) * cv);
}
HD void st_attn(const Prm& p, size_t idx) {
    const int vh = (int)(idx % 2); const int qh = (int)((idx / 2) % (2 * NDH)); const int r = (int)(idx / (4 * NDH));
    const int h = qh / 2, c = qh % 2, b = row_b(r), t = row_t(r);
    const int k0 = b * TPB, nk = t < CTX ? CTX : TPB;
    const bf16_t* Q = WSP(const bf16_t, WS_QKVC);
    float q[QKD], o[QKD];
#pragma unroll
    for (int d = 0; d < QKD; ++d) { q[d] = bf2f(Q[(size_t)r * ABIN + h * VD + c * QKD + d]); o[d] = 0.f; }
    float m = -1e30f, l = 0.f; const float scale = 1.f / sqrtf((float)QKD);
    for (int kk = 0; kk < nk; ++kk) {
        const bf16_t* kr = Q + (size_t)(k0 + kk) * ABIN + DW + h * VD + c * QKD;
        float s = 0.f;
#pragma unroll
        for (int d = 0; d < QKD; ++d) s += q[d] * bf2f(kr[d]);
        s *= scale;
        const float mn = s > m ? s : m, al = expf(m - mn), pe = expf(s - mn);
        l = l * al + pe; m = mn;
        const bf16_t* vr = Q + (size_t)(k0 + kk) * ABIN + 2 * DW + h * VD + vh * QKD;
#pragma unroll
        for (int d = 0; d < QKD; ++d) o[d] = o[d] * al + pe * bf2f(vr[d]);
    }
    float* O = WSP(float, WS_O12) + ((size_t)r * 2 * NDH + qh) * VD + vh * QKD;
    const float il = 1.f / l;
#pragma unroll
    for (int d = 0; d < QKD; ++d) O[d] = o[d] * il;
}
HD void st_combine(const Prm& p, int i_even, size_t idx) {
    const int r = (int)(idx / NDH), h = (int)(idx % NDH);
    const float lam = WSP(const float, WS_LAM)[i_even], li = lam_init_of(i_even);
    const float* o1 = WSP(const float, WS_O12) + ((size_t)r * 2 * NDH + 2 * h) * VD; const float* o2 = o1 + VD;
    float ss = 0.f; for (int d = 0; d < VD; ++d) { const float v = o1[d] - lam * o2[d]; ss += v * v; }
    const float rs = 1.f / sqrtf(ss / VD + 1e-6f);
    const float* g = p.in[I_SUBLN] + (size_t)i_even * VD;
    for (int d = 0; d < VD; ++d) WSP(bf16_t, WS_CAT)[(size_t)r * DM + h * VD + d] = f2bf((o1[d] - lam * o2[d]) * rs * g[d] * (1.f - li));
}

HD void st_ssdconv(const Prm& p, int i_odd, size_t idx) {
    const int per = SSD_CC + 2 * SSD_H; const int r = (int)(idx / per), ch = (int)(idx % per), t = row_t(r);
    const bf16_t* z = WSP(const bf16_t, WS_ZXD) + (size_t)r * SSD_NP;
    if (ch < SSD_CC) {
        const bool first = (t == 0) || (t == CTX), last = (t == CTX - 1) || (t == TPB - 1);
        const float* w = p.in[I_SSDCW] + (size_t)i_odd * 3 * SSD_CC;
        float v = w[SSD_CC + ch] * bf2f(z[SSD_DI + ch]) + p.in[I_SSDCB][(size_t)i_odd * SSD_CC + ch];
        if (!first) v += w[ch] * bf2f(z[-(long)SSD_NP + SSD_DI + ch]);
        if (!last) v += w[2 * SSD_CC + ch] * bf2f(z[(long)SSD_NP + SSD_DI + ch]);
        WSP(bf16_t, WS_XBC)[(size_t)r * SSD_CC + ch] = f2bf(siluf(v));
    } else {
        const int j = ch - SSD_CC;
        WSP(float, WS_DT)[(size_t)r * 2 * SSD_H + j] = softplusf(bf2f(z[SSD_DI + SSD_CC + j]) + p.in[I_SSDDTB][(size_t)i_odd * 2 * SSD_H + j]);
    }
}
HD void st_ssd(const Prm& p, int i_odd, size_t idx) {
    const int pp = (int)(idx % SSD_P); const int h = (int)((idx / SSD_P) % SSD_H); const int dir = (int)((idx / (SSD_P * SSD_H)) % 2); const int b = (int)(idx / (SSD_P * SSD_H * 2));
    const int g = h / SSD_E;
    const float A = -expf(p.in[I_SSDALOG][(size_t)i_odd * 2 * SSD_H + dir * SSD_H + h]);
    float st[SSD_N];
#pragma unroll
    for (int n = 0; n < SSD_N; ++n) st[n] = 0.f;
    const bf16_t* XBC = WSP(const bf16_t, WS_XBC); const float* DT = WSP(const float, WS_DT);
    bf16_t* Y = WSP(bf16_t, WS_YS) + (size_t)dir * R * SSD_DI;
    for (int s = 0; s < TPB; ++s) {
        int t;
        if (dir == 0) t = s; else t = s < CTX ? (CTX - 1 - s) : (TPB - 1 - (s - CTX));
        const size_t r = (size_t)b * TPB + t;
        const float dt = DT[r * 2 * SSD_H + dir * SSD_H + h];
        const float xdt = bf2f(XBC[r * SSD_CC + h * SSD_P + pp]) * dt, dec = expf(dt * A);
        const bf16_t* Bm = XBC + r * SSD_CC + SSD_DI + g * SSD_N; const bf16_t* Cm = Bm + SSD_G * SSD_N;
        float y = 0.f;
#pragma unroll
        for (int n = 0; n < SSD_N; ++n) { st[n] = st[n] * dec + bf2f(Bm[n]) * xdt; y += bf2f(Cm[n]) * st[n]; }
        Y[r * SSD_DI + h * SSD_P + pp] = f2bf(y);
    }
}
HD void st_gnorm(const Prm& p, int i_odd, size_t idx) {
    const int r = (int)(idx / SSD_G), g = (int)(idx % SSD_G); constexpr int GW = SSD_DI / SSD_G;
    const bf16_t* yf = WSP(const bf16_t, WS_YS) + (size_t)r * SSD_DI + g * GW; const bf16_t* yb = yf + (size_t)R * SSD_DI;
    const bf16_t* xs = WSP(const bf16_t, WS_XBC) + (size_t)r * SSD_CC + g * GW; const bf16_t* z = WSP(const bf16_t, WS_ZXD) + (size_t)r * SSD_NP + g * GW;
    const float* Dk = p.in[I_SSDD] + (size_t)i_odd * SSD_H; const float* ng = p.in[I_SSDNG] + (size_t)i_odd * SSD_DI + g * GW;
    float ss = 0.f;
    for (int d = 0; d < GW; ++d) { const float v = (bf2f(yf[d]) + bf2f(yb[d]) + bf2f(xs[d]) * Dk[(g * GW + d) / SSD_P]) * siluf(bf2f(z[d])); ss += v * v; }
    const float rs = 1.f / sqrtf(ss / GW + 1e-6f);
    for (int d = 0; d < GW; ++d) { const float v = (bf2f(yf[d]) + bf2f(yb[d]) + bf2f(xs[d]) * Dk[(g * GW + d) / SSD_P]) * siluf(bf2f(z[d]));
        WSP(bf16_t, WS_YN)[(size_t)r * SSD_DI + g * GW + d] = f2bf(v * rs * ng[d]); }
}

HD void st_norm2_route(const Prm& p, int layer, size_t r) {
    const float* x = WSP(const float, WS_X) + r * DM;
    float ss = 0.f; for (int d = 0; d < DM; ++d) ss += x[d] * x[d];
    const float rs = 1.f / sqrtf(ss / DM + 1e-6f);
    const int j = row_modj((int)r); const float* sh = mod_ptr(p, layer, j, 3); const float* sc = mod_ptr(p, layer, j, 4); const float* g = p.in[I_N2G] + (size_t)layer * DM;
    bf16_t* h = WSP(bf16_t, WS_H) + r * DM;
    float lg[MOE_G], le[MOE_E];
#pragma unroll
    for (int i = 0; i < MOE_G; ++i) lg[i] = p.in[I_MBG][layer * MOE_G + i];
#pragma unroll
    for (int i = 0; i < MOE_E; ++i) le[i] = p.in[I_MBE][layer * MOE_E + i];
    const float* wg = p.in[I_MWG] + (size_t)layer * DM * MOE_G; const float* we = p.in[I_MWE] + (size_t)layer * DM * MOE_E;
    for (int d = 0; d < DM; ++d) { const float v = x[d] * rs * g[d] * (1.f + sc[d]) + sh[d]; h[d] = f2bf(v);
#pragma unroll
        for (int i = 0; i < MOE_G; ++i) lg[i] += v * wg[(size_t)d * MOE_G + i];
#pragma unroll
        for (int i = 0; i < MOE_E; ++i) le[i] += v * we[(size_t)d * MOE_E + i]; }
    int gi = 0; float gm = lg[0];
#pragma unroll
    for (int i = 1; i < MOE_G; ++i) if (lg[i] > gm) { gm = lg[i]; gi = i; }
    float gs = 0.f;
#pragma unroll
    for (int i = 0; i < MOE_G; ++i) gs += expf(lg[i] - gm);
    const float g_w = 1.f / gs;
    float el[MOE_EPG];
#pragma unroll
    for (int i = 0; i < MOE_EPG; ++i) { float v = 0.f;
#pragma unroll
        for (int gg = 0; gg < MOE_G; ++gg) v = (gg == gi) ? le[gg * MOE_EPG + i] : v;
        el[i] = v; }
    int i0 = 0; float m0 = el[0];
#pragma unroll
    for (int i = 1; i < MOE_EPG; ++i) if (el[i] > m0) { m0 = el[i]; i0 = i; }
    int i1 = -1; float m1 = -3.4e38f;
#pragma unroll
    for (int i = 0; i < MOE_EPG; ++i) if (i != i0 && el[i] > m1) { m1 = el[i]; i1 = i; }
    const float p1 = expf(m1 - m0);
    const float w0 = g_w / (1.f + p1), w1 = g_w * p1 / (1.f + p1);
    const int e0 = gi * MOE_EPG + i0, e1 = gi * MOE_EPG + i1;
    int* cnt = WSP(int, WS_CNT) + layer * MOE_E;
    const int r0 = atomic_add_int(&cnt[e0], 1), r1 = atomic_add_int(&cnt[e1], 1);
    int* ro = WSP(int, WS_ROUTE) + r * 8;
    ro[0] = e0; ro[1] = e1; ro[2] = r0; ro[3] = r1; memcpy(&ro[4], &w0, 4); memcpy(&ro[5], &w1, 4);
}
HD int moe_off(const int* cnt, int e) { int o = 0; for (int i = 0; i < e; ++i) o += (cnt[i] + MOE_MT - 1) / MOE_MT * MOE_MT; return o; }
HD int moe_slot_expert(const int* cnt, int slot, int& off) { int o = 0; for (int i = 0; i < MOE_E; ++i) { const int pc = (cnt[i] + MOE_MT - 1) / MOE_MT * MOE_MT; if (slot < o + pc) { off = o; return i; } o += pc; } off = o; return -1; }
HD void st_gather(const Prm& p, int layer, size_t idx) {
    const size_t r = idx / 2; const int j = (int)(idx % 2);
    int* ro = WSP(int, WS_ROUTE) + r * 8; const int* cnt = WSP(const int, WS_CNT) + layer * MOE_E;
    const int slot = moe_off(cnt, ro[j]) + ro[2 + j];
    ro[6 + j] = slot;
    const bf16_t* h = WSP(const bf16_t, WS_H) + r * DM; bf16_t* xb = WSP(bf16_t, WS_XB) + (size_t)slot * DM;
    for (int d = 0; d < DM; ++d) xb[d] = h[d];
}
HD void st_moe1(const Prm& p, int layer, size_t idx) {
    const int jb = (int)(idx % (MOE_HID / 4)) * 4; const int slot = (int)(idx / (MOE_HID / 4));
    const int* cnt = WSP(const int, WS_CNT) + layer * MOE_E; int off; const int e = moe_slot_expert(cnt, slot, off);
    if (e < 0 || slot - off >= cnt[e]) return;
    const bf16_t* xb = WSP(const bf16_t, WS_XB) + (size_t)slot * DM; const bf16_t* w1 = WSP(const bf16_t, WS_W1) + (size_t)e * 2 * MOE_HID * DM;
    for (int j = jb; j < jb + 4; ++j) {
        const int pn = j / MOE_HB, jj = j % MOE_HB; const bf16_t* wgr = w1 + (size_t)(pn * 2 * MOE_HB + jj) * DM; const bf16_t* wur = wgr + (size_t)MOE_HB * DM;
        float ga = 0.f, up = 0.f;
        for (int k = 0; k < DM; ++k) { const float xv = bf2f(xb[k]); ga += xv * bf2f(wgr[k]); up += xv * bf2f(wur[k]); }
        WSP(bf16_t, WS_ACT)[(size_t)slot * MOE_HID + j] = f2bf(siluf(ga) * up);
    }
}
HD void st_moe2(const Prm& p, int layer, size_t idx) {
    const int nb = (int)(idx % (DM / 4)) * 4; const int slot = (int)(idx / (DM / 4));
    const int* cnt = WSP(const int, WS_CNT) + layer * MOE_E; int off; const int e = moe_slot_expert(cnt, slot, off);
    if (e < 0 || slot - off >= cnt[e]) return;
    const bf16_t* a = WSP(const bf16_t, WS_ACT) + (size_t)slot * MOE_HID; const bf16_t* w2 = WSP(const bf16_t, WS_W2) + (size_t)e * DM * MOE_HID;
    for (int n = nb; n < nb + 4; ++n) { float acc = 0.f; const bf16_t* wr = w2 + (size_t)n * MOE_HID;
        for (int k = 0; k < MOE_HID; ++k) acc += bf2f(a[k]) * bf2f(wr[k]);
        WSP(bf16_t, WS_YB)[(size_t)slot * DM + n] = f2bf(acc); }
}
HD void st_moe_comb(const Prm& p, int layer, size_t idx) {
    const size_t r = idx / DM; const int d = (int)(idx % DM);
    const int* ro = WSP(const int, WS_ROUTE) + r * 8; float w0, w1; memcpy(&w0, &ro[4], 4); memcpy(&w1, &ro[5], 4);
    const float* gate = mod_ptr(p, layer, row_modj((int)r), 5);
    const bf16_t* yb = WSP(const bf16_t, WS_YB);
    WSP(float, WS_X)[idx] += gate[d] * (w0 * bf2f(yb[(size_t)ro[6] * DM + d]) + w1 * bf2f(yb[(size_t)ro[7] * DM + d]));
}
HD void st_final(const Prm& p, size_t idx) {
    const int b = (int)(idx / SEQ), t = (int)(idx % SEQ); const size_t r = (size_t)b * TPB + CTX + t;
    const float* x = WSP(const float, WS_X) + r * DM;
    float ss = 0.f; for (int d = 0; d < DM; ++d) ss += x[d] * x[d];
    const float rs = 1.f / sqrtf(ss / DM + 1e-6f);
    for (int d = 0; d < DM; ++d) p.out[idx * DM + d] = x[d] * rs * p.in[I_FNG][d];
}

enum { ST_PROLOG_W, ST_MODS, ST_XINIT, ST_MISC, ST_MOE_W, ST_NORM1, ST_G1E, ST_ROPE, ST_BCONV, ST_ATTN, ST_COMBINE, ST_G2E,
       ST_G1O, ST_SSDCONV, ST_SSD, ST_GNORM, ST_G2O, ST_N2RT, ST_GATHER, ST_MOE1, ST_MOE2, ST_MOECOMB, ST_FINAL, N_ST };
HD size_t stage_items(int st) {
    switch (st) {
    case ST_PROLOG_W: return N_PROLOG_W; case ST_MODS: return N_MODS; case ST_XINIT: return (size_t)R * DM; case ST_MISC: return N_MISC; case ST_MOE_W: return N_MOE_W;
    case ST_NORM1: return R; case ST_G1E: return (size_t)(R / 4) * (ABIN / 4); case ST_ROPE: return (size_t)R * ROPE_PAIRS; case ST_BCONV: return (size_t)R * CW;
    case ST_ATTN: return (size_t)R * 4 * NDH; case ST_COMBINE: return (size_t)R * NDH; case ST_G2E: return (size_t)(R / 4) * (DM / 4);
    case ST_G1O: return (size_t)(R / 4) * (SSD_NP / 4); case ST_SSDCONV: return (size_t)R * (SSD_CC + 2 * SSD_H); case ST_SSD: return (size_t)NB * 2 * SSD_H * SSD_P;
    case ST_GNORM: return (size_t)R * SSD_G; case ST_G2O: return (size_t)(R / 4) * (DM / 4); case ST_N2RT: return R; case ST_GATHER: return (size_t)R * 2;
    case ST_MOE1: return (size_t)NSLOT * (MOE_HID / 4); case ST_MOE2: return (size_t)NSLOT * (DM / 4); case ST_MOECOMB: return (size_t)R * DM; case ST_FINAL: return (size_t)NB * SEQ;
    } return 0;
}
template <int ST> HD void stage_item(const Prm& p, int layer, size_t idx) {
    const int ih = layer / 2;
    if constexpr (ST == ST_PROLOG_W) st_prolog_w(p, idx);
    else if constexpr (ST == ST_MODS) st_mods(p, idx);
    else if constexpr (ST == ST_XINIT) st_xinit(p, idx);
    else if constexpr (ST == ST_MISC) st_misc(p, idx);
    else if constexpr (ST == ST_MOE_W) st_moe_w(p, layer, idx);
    else if constexpr (ST == ST_NORM1) st_norm1(p, layer, idx);
    else if constexpr (ST == ST_G1E) st_gemm_bf16(WSP(const bf16_t, WS_H), DM, WSP(const bf16_t, WS_WABIN) + (size_t)ih * ABIN * DM, ABIN, WSP(bf16_t, WS_QKVC), idx);
    else if constexpr (ST == ST_ROPE) st_rope(p, idx);
    else if constexpr (ST == ST_BCONV) st_bconv(p, ih, idx);
    else if constexpr (ST == ST_ATTN) st_attn(p, idx);
    else if constexpr (ST == ST_COMBINE) st_combine(p, ih, idx);
    else if constexpr (ST == ST_G2E) st_gemm_res(p, layer, WSP(const bf16_t, WS_CAT), DM, WSP(const bf16_t, WS_WABOUT) + (size_t)ih * DM * DM, idx);
    else if constexpr (ST == ST_G1O) st_gemm_bf16(WSP(const bf16_t, WS_H), DM, WSP(const bf16_t, WS_WSIN) + (size_t)ih * SSD_NP * DM, SSD_NP, WSP(bf16_t, WS_ZXD), idx);
    else if constexpr (ST == ST_SSDCONV) st_ssdconv(p, ih, idx);
    else if constexpr (ST == ST_SSD) st_ssd(p, ih, idx);
    else if constexpr (ST == ST_GNORM) st_gnorm(p, ih, idx);
    else if constexpr (ST == ST_G2O) st_gemm_res(p, layer, WSP(const bf16_t, WS_YN), SSD_DI, WSP(const bf16_t, WS_WSOUT) + (size_t)ih * DM * SSD_DI, idx);
    else if constexpr (ST == ST_N2RT) st_norm2_route(p, layer, idx);
    else if constexpr (ST == ST_GATHER) st_gather(p, layer, idx);
    else if constexpr (ST == ST_MOE1) st_moe1(p, layer, idx);
    else if constexpr (ST == ST_MOE2) st_moe2(p, layer, idx);
    else if constexpr (ST == ST_MOECOMB) st_moe_comb(p, layer, idx);
    else if constexpr (ST == ST_FINAL) st_final(p, idx);
}

template <int layer, class Runner> HD void layer_program(Runner& run) {
    run.template go<ST_MOE_W>(layer); run.template go<ST_NORM1>(layer); run.sync();
    if constexpr (layer % 2 == 0) {
        run.template go<ST_G1E>(layer); run.sync();
        run.template go<ST_ROPE>(layer); run.template go<ST_BCONV>(layer); run.sync();
        run.template go<ST_ATTN>(layer); run.sync();
        run.template go<ST_COMBINE>(layer); run.sync();
        run.template go<ST_G2E>(layer); run.sync();
    } else {
        run.template go<ST_G1O>(layer); run.sync();
        run.template go<ST_SSDCONV>(layer); run.sync();
        run.template go<ST_SSD>(layer); run.sync();
        run.template go<ST_GNORM>(layer); run.sync();
        run.template go<ST_G2O>(layer); run.sync();
    }
    run.template go<ST_N2RT>(layer); run.sync();
    run.template go<ST_GATHER>(layer); run.sync();
    run.template go<ST_MOE1>(layer); run.sync();
    run.template go<ST_MOE2>(layer); run.sync();
    run.template go<ST_MOECOMB>(layer); run.sync();
}
template <class Runner> HD void forward_program(Runner& run) {
    run.template go<ST_PROLOG_W>(0); run.template go<ST_MODS>(0); run.template go<ST_XINIT>(0); run.template go<ST_MISC>(0); run.sync();
    layer_program<0>(run); layer_program<1>(run); layer_program<2>(run); layer_program<3>(run);
    static_assert(DEPTH == 4, "layers are unrolled by hand");
    run.template go<ST_FINAL>(0);
}

#ifndef CPU_EMU
#define XB_TMO      128
#define XB_XCNT(j)  (256  + 64 * (j))
#define XB_XSUB(j)  (1280 + 64 * (j))
#define XB_XGEN(j)  (2304 + 64 * (j))
#define XB_TOP      3328
#define XB_TOPGEN   3392
#define XCD_BAR_WORDS 3456
#define XB_SPIN_CAP (1u << 22)
#define LAS __attribute__((address_space(3)))

__device__ __forceinline__ unsigned xb_ld(unsigned* p)              { return __hip_atomic_load(p, __ATOMIC_RELAXED, __HIP_MEMORY_SCOPE_AGENT); }
__device__ __forceinline__ unsigned xb_add(unsigned* p, unsigned v) { return __hip_atomic_fetch_add(p, v, __ATOMIC_RELAXED, __HIP_MEMORY_SCOPE_AGENT); }
__device__ __forceinline__ unsigned xb_xcc_id() { return (unsigned)__builtin_amdgcn_s_getreg((3 << 11) | 20) & 0xFu; }
#define XB_SPIN(cond, bar) do { unsigned _sp = 0; while (cond) { __builtin_amdgcn_s_sleep(1); \
    if ((++_sp & 255u) == 0u) { if (xb_ld(&(bar)[XB_TMO])) break; if (_sp > XB_SPIN_CAP) { atomicAdd(&(bar)[XB_TMO], 1u); break; } } } } while (0)

struct XcdBarrier {
    unsigned* bar; unsigned x;
    volatile LAS unsigned* st;
};
__device__ __forceinline__ XcdBarrier xcd_barrier_post(unsigned* bar, volatile LAS unsigned* st) {
    XcdBarrier b; b.bar = bar; b.x = xb_xcc_id(); b.st = st;
    if (threadIdx.x == 0) (void)xb_add(&bar[XB_XCNT(b.x)], 1u);
    return b;
}
__device__ __forceinline__ void xcd_barrier_complete(unsigned* bar, unsigned x, unsigned& nloc, unsigned& nx) {
    const unsigned G = gridDim.x * gridDim.y * gridDim.z;
    unsigned sum, cnt, mine, sp = 0u;
    for (;;) {
        sum = 0u; cnt = 0u; mine = 0u;
#pragma unroll
        for (unsigned j = 0; j < 16; ++j) { const unsigned c = xb_ld(&bar[XB_XCNT(j)]); sum += c; cnt += (c > 0u) ? 1u : 0u; mine = (j == x) ? c : mine; }
        if (sum == G) break;
        __builtin_amdgcn_s_sleep(1);
        if ((++sp & 255u) == 0u) { if (xb_ld(&bar[XB_TMO])) break; if (sp > XB_SPIN_CAP) { atomicAdd(&bar[XB_TMO], 1u); break; } }
    }
    nloc = mine > 0u ? mine : 1u; nx = cnt > 0u ? cnt : 1u;
}
__device__ __forceinline__ void xcd_barrier(const XcdBarrier& b) {
    asm volatile("s_waitcnt vmcnt(0)" ::: "memory");
    __syncthreads();
    if (threadIdx.x == 0) {
        unsigned* bar = b.bar;
        __builtin_amdgcn_s_waitcnt(0);
        unsigned nloc = b.st[0], nx = b.st[1];
        if (nloc == 0u) { xcd_barrier_complete(bar, b.x, nloc, nx); b.st[0] = nloc; b.st[1] = nx; }
        const unsigned old = xb_add(&bar[XB_XSUB(b.x)], 1u);
        const unsigned gen = old / nloc;
        if (old + 1u == (gen + 1u) * nloc) {
            __builtin_amdgcn_fence(__ATOMIC_RELEASE, "agent");
            asm volatile("s_waitcnt vmcnt(0)" ::: "memory");
            const unsigned og = xb_add(&bar[XB_TOP], 1u);
            const unsigned tg = og / nx;
            if (og + 1u == (tg + 1u) * nx) xb_add(&bar[XB_TOPGEN], 1u);
            else XB_SPIN(xb_ld(&bar[XB_TOPGEN]) == tg, bar);
            __builtin_amdgcn_fence(__ATOMIC_ACQUIRE, "agent");
            xb_add(&bar[XB_XGEN(b.x)], 1u);
            asm volatile("s_waitcnt vmcnt(0)" ::: "memory");
        } else {
            XB_SPIN(xb_ld(&bar[XB_XGEN(b.x)]) == gen, bar);
            __builtin_amdgcn_fence(__ATOMIC_ACQUIRE, "agent");
            asm volatile("s_waitcnt vmcnt(0)" ::: "memory");
        }
    }
    __syncthreads();
}

namespace pg8 {
#define PG8_LAS __attribute__((address_space(3)))
typedef unsigned short bf16_t;
typedef short bf16x8 __attribute__((ext_vector_type(8)));
typedef float f32x4 __attribute__((ext_vector_type(4)));
typedef unsigned u32x4 __attribute__((ext_vector_type(4)));
constexpr int BM = 256, BK = 64, HALF = 128, HTB = HALF * BK * 2  , STAGE_BYTES = 8 * HTB, NXCD = 8, WGM = 8;

__host__ __device__ __forceinline__ int lds_byte(int r, int c) { const int st = (r >> 4) * 2 + (c >> 5), rr = r & 15, cc = c & 31, ob = rr * 64 + cc * 2; return st * 1024 + (ob ^ (((ob >> 9) & 1) << 5)); }
__host__ __device__ __forceinline__ void stage_rc(int b, int& R, int& C) { const int st = b / 1024, sb = b % 1024, swz = sb ^ (((sb >> 9) & 1) << 5); R = (st >> 1) * 16 + swz / 64; C = (st & 1) * 32 + (swz % 64) / 2; }
__host__ __device__ __forceinline__ int perm32(int rho) { const int n = rho >> 4, i = rho & 15; return 8 * (i >> 2) + 4 * n + (i & 3); }

struct Unit { int pm, pn, pb, ui; };
struct Gemm { const bf16_t* A; const bf16_t* Bt; int M, N, K; };

struct StaticOrder {
    int nM, nN, nwg, G, c;
    __host__ __device__ void init(int M, int N, int G_, int c_) { nM = M / BM; nN = N / BM; nwg = nM * nN; G = G_; c = c_; }
    __host__ __device__ bool next(int i, Unit& u) const {
        const long L = (long)i * G + c; if (L >= nwg) return false;
        int wgid = (int)L; { const int q = nwg / NXCD, r = nwg % NXCD, xcd = wgid % NXCD, off = wgid / NXCD; wgid = (xcd < r ? xcd * (q + 1) : r * (q + 1) + (xcd - r) * q) + off; }
        const int nig = WGM * nN, gid = wgid / nig, fm = gid * WGM, gsz = (nM - fm) < WGM ? (nM - fm) : WGM;
        u.pm = fm + ((wgid % nig) % gsz); u.pn = (wgid % nig) / gsz; u.pb = u.pn; u.ui = i; return true;
    }
    __device__ __forceinline__ void a_ready(const Unit&) const {}
    __device__ __forceinline__ void done(const Unit&) const {}
};

__device__ __forceinline__ unsigned cvt_pk_bf16(float lo, float hi) { unsigned r; asm volatile("v_cvt_pk_bf16_f32 %0, %1, %2" : "=v"(r) : "v"(lo), "v"(hi)); return r; }

struct EpiStore {
    static constexpr bool PERM = true, AFTER_DRAIN = false;
    bf16_t* O; int ldc;
    __device__ __forceinline__ void operator()(const f32x4 (&acc)[2][2][4][2], const Unit& u, int wr, int wc, int fr, int fq) const {
        const int row0 = u.pm * BM + wr * 64 + fr, col0 = u.pn * BM + wc * 32 + 8 * fq;
#pragma unroll
        for (int ai = 0; ai < 2; ++ai)
#pragma unroll
            for (int m = 0; m < 4; ++m) { bf16_t* rowp = O + (size_t)(row0 + ai * HALF + m * 16) * ldc + col0;
#pragma unroll
                for (int bj = 0; bj < 2; ++bj) { const f32x4 v0 = acc[ai][bj][m][0], v1 = acc[ai][bj][m][1];
                    u32x4 w; w.x = cvt_pk_bf16(v0[0], v0[1]); w.y = cvt_pk_bf16(v0[2], v0[3]); w.z = cvt_pk_bf16(v1[0], v1[1]); w.w = cvt_pk_bf16(v1[2], v1[3]);
                    *(u32x4*)(rowp + bj * HALF) = w; } }
    }
};
struct EpiStoreRope {
    static constexpr bool PERM = true, AFTER_DRAIN = false;
    bf16_t* O; int ldc; const float* tab; int ropeTiles;
    __device__ __forceinline__ void operator()(const f32x4 (&acc)[2][2][4][2], const Unit& u, int wr, int wc, int fr, int fq) const {
        constexpr int TPT = TPB / BM;
        const int row0 = u.pm * BM + wr * 64 + fr, col0 = u.pn * BM + wc * 32 + 8 * fq;
        const bool rope = (u.pn < ropeTiles) && (u.pm % TPT != 0);
        const float sg = fq < 2 ? -1.f : 1.f; const int axis = wc & 1;
#pragma unroll
        for (int ai = 0; ai < 2; ++ai)
#pragma unroll
            for (int m = 0; m < 4; ++m) { const int row = row0 + ai * HALF + m * 16; bf16_t* rowp = O + (size_t)row * ldc + col0;
                f32x4 cs[4];
                if (rope) { const int pos = row % TPB - CTX; const int pv = axis ? pos % GRID_W : pos / GRID_W; const float* tp = tab + ((size_t)pv * 16 + 8 * (fq & 1)) * 2;
#pragma unroll
                    for (int i = 0; i < 4; ++i) cs[i] = *(const f32x4*)(tp + 4 * i); }
#pragma unroll
                for (int bj = 0; bj < 2; ++bj) { f32x4 v0 = acc[ai][bj][m][0], v1 = acc[ai][bj][m][1];
                    if (rope) { float mine[8] = {v0[0], v0[1], v0[2], v0[3], v1[0], v1[1], v1[2], v1[3]}, o[8];
#pragma unroll
                        for (int j = 0; j < 8; ++j) { const unsigned mu = __float_as_uint(mine[j]); auto sw = __builtin_amdgcn_permlane32_swap(mu, mu, false, false);
                            const float other = __uint_as_float(fq < 2 ? sw[1] : sw[0]);
                            const float c = cs[j >> 1][(j & 1) * 2], s = cs[j >> 1][(j & 1) * 2 + 1]; o[j] = mine[j] * c + sg * other * s; }
                        v0 = (f32x4){o[0], o[1], o[2], o[3]}; v1 = (f32x4){o[4], o[5], o[6], o[7]}; }
                    u32x4 w; w.x = cvt_pk_bf16(v0[0], v0[1]); w.y = cvt_pk_bf16(v0[2], v0[3]); w.z = cvt_pk_bf16(v1[0], v1[1]); w.w = cvt_pk_bf16(v1[2], v1[3]);
                    *(u32x4*)(rowp + bj * HALF) = w; } }
    }
};
struct EpiResid {
    static constexpr bool PERM = true, AFTER_DRAIN = false;
    bf16_t* X; const float* mods_layer; int which; int ldx;
    __device__ __forceinline__ void operator()(const f32x4 (&acc)[2][2][4][2], const Unit& u, int wr, int wc, int fr, int fq) const {
        constexpr int TPT = TPB / BM;
        const int j = (u.pm % TPT == 0) ? NB : u.pm / TPT;
        const float* gate = mods_layer + ((size_t)j * 6 + which) * ldx;
        const int row0 = u.pm * BM + wr * 64 + fr, col0 = u.pn * BM + wc * 32 + 8 * fq;
        f32x4 gv[2][2];
#pragma unroll
        for (int bj = 0; bj < 2; ++bj)
#pragma unroll
            for (int n = 0; n < 2; ++n) gv[bj][n] = *(const f32x4*)(gate + col0 + bj * HALF + 4 * n);
#pragma unroll
        for (int ai = 0; ai < 2; ++ai) {
            u32x4 xin[4][2];
#pragma unroll
            for (int m = 0; m < 4; ++m)
#pragma unroll
                for (int bj = 0; bj < 2; ++bj) xin[m][bj] = *(const u32x4*)(X + (size_t)(row0 + ai * HALF + m * 16) * ldx + col0 + bj * HALF);
#pragma unroll
            for (int m = 0; m < 4; ++m) { bf16_t* rowp = X + (size_t)(row0 + ai * HALF + m * 16) * ldx + col0;
#pragma unroll
                for (int bj = 0; bj < 2; ++bj) { u32x4* q = (u32x4*)(rowp + bj * HALF); const u32x4 xo = xin[m][bj];
                    const f32x4 v0 = gv[bj][0] * acc[ai][bj][m][0], v1 = gv[bj][1] * acc[ai][bj][m][1];
                    u32x4 w;
                    w.x = cvt_pk_bf16(__uint_as_float(xo.x << 16) + v0[0], __uint_as_float(xo.x & 0xffff0000u) + v0[1]); w.y = cvt_pk_bf16(__uint_as_float(xo.y << 16) + v0[2], __uint_as_float(xo.y & 0xffff0000u) + v0[3]);
                    w.z = cvt_pk_bf16(__uint_as_float(xo.z << 16) + v1[0], __uint_as_float(xo.z & 0xffff0000u) + v1[1]); w.w = cvt_pk_bf16(__uint_as_float(xo.w << 16) + v1[2], __uint_as_float(xo.w & 0xffff0000u) + v1[3]);
                    *q = w; } } }
    }
};
struct EpiSwiGLU {
    static constexpr bool PERM = true, AFTER_DRAIN = false;
    bf16_t* O; int ldc;
    __device__ __forceinline__ void operator()(const f32x4 (&acc)[2][2][4][2], const Unit& u, int wr, int wc, int fr, int fq) const {
        const int row0 = u.pm * BM + wr * 64 + fr, col0 = u.pn * HALF + wc * 32 + 8 * fq;
#pragma unroll
        for (int ai = 0; ai < 2; ++ai)
#pragma unroll
            for (int m = 0; m < 4; ++m) { float v[8];
#pragma unroll
                for (int n = 0; n < 2; ++n)
#pragma unroll
                    for (int i = 0; i < 4; ++i) { const float g = acc[ai][0][m][n][i], up = acc[ai][1][m][n][i]; v[n * 4 + i] = g * __builtin_amdgcn_rcpf(1.f + __expf(-g)) * up; }
                u32x4 w; w.x = cvt_pk_bf16(v[0], v[1]); w.y = cvt_pk_bf16(v[2], v[3]); w.z = cvt_pk_bf16(v[4], v[5]); w.w = cvt_pk_bf16(v[6], v[7]);
                *(u32x4*)(O + (size_t)(row0 + ai * HALF + m * 16) * ldc + col0) = w; }
    }
};
struct LatentOrder {
    int G, c, nN;
    __device__ __forceinline__ bool next(int i, Unit& u) const {
        constexpr int TPT = TPB / BM, NLT = NB * (TPT - 1);
        const long L = (long)i * G + c; if (L >= (long)NLT * nN) return false;
        const int mtl = (int)(L / nN); u.pm = (mtl / (TPT - 1)) * TPT + 1 + mtl % (TPT - 1); u.pn = (int)(L % nN); u.pb = u.pn; u.ui = i; return true;
    }
    __device__ __forceinline__ void a_ready(const Unit&) const {}
    __device__ __forceinline__ void done(const Unit&) const {}
};
struct MoeOrder {
    const PG8_LAS int* pref;
    int G, c, ntn;
    __device__ __forceinline__ bool next(int i, Unit& u) const {
        const long L = (long)i * G + c; const int mt = (int)(L / ntn), pn = (int)(L % ntn);
        if (mt >= pref[MOE_E]) return false;
        int e = 0;
#pragma unroll
        for (int q = 1; q < MOE_E; ++q) e = (mt >= pref[q]) ? q : e;
        u.pm = mt; u.pn = pn; u.pb = e * ntn + pn; u.ui = i; return true;
    }
    __device__ __forceinline__ void a_ready(const Unit&) const {}
    __device__ __forceinline__ void done(const Unit&) const {}
};

template <class Epi, class Sched, bool ALIGN_EPI = false, bool SP2 = false, bool GATHER = false>
__device__ __forceinline__ void gemm_phase(PG8_LAS unsigned char* lds, const Gemm g, const Sched& S, const Epi& E, const PG8_LAS int* rowtok = nullptr) {
    int tid_ = threadIdx.x; asm volatile("" : "+v"(tid_));
    const int tid = tid_, wid = __builtin_amdgcn_readfirstlane(tid >> 6), lane = tid & 63, wr = wid >> 2, wc = wid & 3, fr = lane & 15, fq = lane >> 4;
    const int K = g.K, nt = K / BK;
    unsigned voffA[2], voffB[2];
#pragma unroll
    for (int i = 0; i < 2; ++i) { int R, C; stage_rc(tid * 16 + i * 8192, R, C); const int Rb = Epi::PERM ? ((R & ~31) + perm32(R & 31)) : R;
        voffA[i] = (unsigned)(R * K + C) * 2u; voffB[i] = (unsigned)(Rb * K + C) * 2u; }
    unsigned gv[2][2] = {{0u, 0u}, {0u, 0u}};
#define PG8_GV(dst, u) do { if constexpr (GATHER) { _Pragma("unroll") for (int i_ = 0; i_ < 2; ++i_) { int R_, C_; stage_rc(tid * 16 + i_ * 8192, R_, C_); _Pragma("unroll") for (int h_ = 0; h_ < 2; ++h_) \
        dst[h_][i_] = (unsigned)(rowtok[(u).ui * BM + h_ * HALF + R_] * K + C_) * 2u; } } } while (0)
    const size_t kstep = (size_t)(BK * 2);
    const size_t hstep = (size_t)HALF * K * 2;
    const size_t tstep = 2 * hstep;
    const unsigned ldsw = (unsigned)wid * 1024u;
    const int aoff = lds_byte(wr * 64 + fr, fq * 8), boff = lds_byte(wc * 32 + fr, fq * 8);
#define PG8_SA(b, h) (((b) * 2 + (h)) * HTB)
#define PG8_SB(b, h) ((4 + (b) * 2 + (h)) * HTB)
#define PG8_STAGE(bufoff, gbase, voff) do { _Pragma("unroll") for (int _i = 0; _i < 2; ++_i) \
        __builtin_amdgcn_global_load_lds((const unsigned*)((const char*)(gbase) + (voff)[_i]), (PG8_LAS unsigned*)(lds + (bufoff) + ldsw + _i * 8192), 16, 0, 0); } while (0)
#define PG8_STA(bufoff, ptr, half, nx) do { if constexpr (GATHER) { unsigned v_[2] = { gv[half][0], gv[half][1] }; \
            if ((nx) && last && has_next_) { _Pragma("unroll") for (int i_ = 0; i_ < 2; ++i_) { int R_, C_; stage_rc(tid * 16 + i_ * 8192, R_, C_); v_[i_] = (unsigned)(rowtok[nxt.ui * BM + (half) * HALF + R_] * K + C_) * 2u; } } \
            PG8_STAGE(bufoff, ptr, v_); } \
        else { PG8_STAGE(bufoff, (ptr) + (half) * hstep, voffA); } } while (0)
#define PG8_LDA(dst, b, h) do { _Pragma("unroll") for (int m = 0; m < 4; ++m) _Pragma("unroll") for (int k = 0; k < 2; ++k) dst[m][k] = *(const PG8_LAS bf16x8*)(lds + PG8_SA(b, h) + aoff + m * 2048 + k * 1024); } while (0)
#define PG8_LDB(dst, b, h) do { _Pragma("unroll") for (int n = 0; n < 2; ++n) _Pragma("unroll") for (int k = 0; k < 2; ++k) dst[n][k] = *(const PG8_LAS bf16x8*)(lds + PG8_SB(b, h) + boff + n * 2048 + k * 1024); } while (0)
#define PG8_MMA(ai, bj, At, Bt) do { __builtin_amdgcn_s_setprio(1); _Pragma("unroll") for (int m = 0; m < 4; ++m) _Pragma("unroll") for (int n = 0; n < 2; ++n) _Pragma("unroll") for (int k = 0; k < 2; ++k) \
        acc[ai][bj][m][n] = __builtin_amdgcn_mfma_f32_16x16x32_bf16(Bt[n][k], At[m][k], acc[ai][bj][m][n], 0, 0, 0); __builtin_amdgcn_s_setprio(0); } while (0)
#define PG8_WAIT_V(n) asm volatile("s_waitcnt vmcnt(" #n ")" ::: "memory")
#define PG8_WAIT_L(n) asm volatile("s_waitcnt lgkmcnt(" #n ")" ::: "memory")
#define PG8_BAR __builtin_amdgcn_s_barrier()
#define PG8_SCHED __builtin_amdgcn_sched_barrier(0)
    Unit cur, nxt; int ui = 0;
    if (!S.next(0, cur)) return;
    f32x4 acc[2][2][4][2];
#pragma unroll
    for (int a = 0; a < 2; ++a)
#pragma unroll
        for (int b = 0; b < 2; ++b)
#pragma unroll
            for (int m = 0; m < 4; ++m)
#pragma unroll
                for (int n = 0; n < 2; ++n) acc[a][b][m][n] = (f32x4){0.f, 0.f, 0.f, 0.f};
    bf16x8 At[4][2], B0[2][2], B1[2][2];
    const char* cA = (const char*)g.A + (GATHER ? (size_t)0 : (size_t)cur.pm * tstep); const char* cB = (const char*)g.Bt + (size_t)cur.pb * tstep;
    PG8_GV(gv, cur);
    S.a_ready(cur);
    if constexpr (SP2) {
        { constexpr bool last = false, has_next_ = false; PG8_STAGE(PG8_SB(0, 0), cB, voffB); PG8_STAGE(PG8_SB(0, 1), cB + hstep, voffB); PG8_STA(PG8_SA(0, 0), cA, 0, false); PG8_STA(PG8_SA(0, 1), cA, 1, false); }
        if (wr == 1) PG8_BAR;
        PG8_WAIT_V(2); PG8_BAR;
        { constexpr bool last = false, has_next_ = false; PG8_STAGE(PG8_SB(1, 0), cB + kstep, voffB); PG8_STA(PG8_SA(1, 0), cA + kstep, 0, false); PG8_STAGE(PG8_SB(1, 1), cB + hstep + kstep, voffB); }
        PG8_WAIT_V(6); PG8_BAR;
    } else {
        PG8_STAGE(PG8_SB(0, 0), cB, voffB); PG8_STAGE(PG8_SA(0, 0), cA, voffA); PG8_STAGE(PG8_SB(0, 1), cB + hstep, voffB); PG8_STAGE(PG8_SA(0, 1), cA + hstep, voffA);
        if (wr == 1) PG8_BAR;
        PG8_WAIT_V(4); PG8_BAR;
        PG8_STAGE(PG8_SB(1, 0), cB + kstep, voffB); PG8_STAGE(PG8_SA(1, 0), cA + kstep, voffA); PG8_STAGE(PG8_SB(1, 1), cB + hstep + kstep, voffB);
        PG8_WAIT_V(6); PG8_BAR;
    }
    for (;;) {
        const bool has_next = S.next(ui + 1, nxt);
        const char* nA = has_next ? (const char*)g.A + (GATHER ? (size_t)0 : (size_t)nxt.pm * tstep) : cA; const char* nB = has_next ? (const char*)g.Bt + (size_t)nxt.pb * tstep : cB;
        const bool has_next_ = has_next;
        for (int t = 0; t < nt; t += 2) {
            const bool last = (t == nt - 2);
            const char* a1 = cA + (size_t)(t + 1) * kstep;
            const char* a2 = last ? nA : cA + (size_t)(t + 2) * kstep; const char* b2 = last ? nB : cB + (size_t)(t + 2) * kstep;
            const char* a3 = a2 + kstep; const char* b3 = b2 + kstep;
            if (last && has_next) S.a_ready(nxt);
            if constexpr (SP2) {
            PG8_LDB(B0, 0, 0); PG8_LDB(B1, 0, 1); PG8_SCHED; PG8_LDA(At, 0, 0); PG8_STA(PG8_SA(1, 1), a1, 1, false);
            PG8_WAIT_V(8); PG8_WAIT_L(0); PG8_BAR; PG8_MMA(0, 0, At, B0); PG8_MMA(0, 1, At, B1); PG8_BAR; PG8_SCHED;
            PG8_LDA(At, 0, 1); PG8_STAGE(PG8_SB(0, 0), b2, voffB); PG8_STAGE(PG8_SB(0, 1), b2 + hstep, voffB); PG8_STA(PG8_SA(0, 0), a2, 0, true);
            PG8_WAIT_V(8); PG8_WAIT_L(0); PG8_BAR; PG8_MMA(1, 0, At, B0); PG8_MMA(1, 1, At, B1); PG8_BAR; PG8_SCHED;
            PG8_LDB(B0, 1, 0); PG8_LDB(B1, 1, 1); PG8_SCHED; PG8_LDA(At, 1, 0); PG8_STA(PG8_SA(0, 1), a2, 1, true);
            PG8_WAIT_V(8); PG8_WAIT_L(0); PG8_BAR; PG8_MMA(0, 0, At, B0); PG8_MMA(0, 1, At, B1); PG8_BAR; PG8_SCHED;
            PG8_LDA(At, 1, 1); PG8_STAGE(PG8_SB(1, 0), b3, voffB); PG8_STAGE(PG8_SB(1, 1), b3 + hstep, voffB); PG8_STA(PG8_SA(1, 0), a3, 0, true);
            PG8_WAIT_V(8); PG8_WAIT_L(0); PG8_BAR; PG8_MMA(1, 0, At, B0); PG8_MMA(1, 1, At, B1); PG8_BAR; PG8_SCHED;
            } else {
            PG8_LDB(B0, 0, 0); PG8_SCHED; PG8_LDA(At, 0, 0); PG8_STAGE(PG8_SA(1, 1), a1 + hstep, voffA);
            PG8_WAIT_L(8); PG8_BAR; PG8_WAIT_L(0); PG8_MMA(0, 0, At, B0); PG8_BAR; PG8_SCHED;
            PG8_LDB(B1, 0, 1); PG8_STAGE(PG8_SB(0, 0), b2, voffB);
            PG8_BAR; PG8_WAIT_L(0); PG8_MMA(0, 1, At, B1); PG8_BAR;
            PG8_LDA(At, 0, 1); PG8_STAGE(PG8_SA(0, 0), a2, voffA);
            PG8_BAR; PG8_WAIT_L(0); PG8_MMA(1, 0, At, B0); PG8_BAR; PG8_SCHED;
            PG8_STAGE(PG8_SB(0, 1), b2 + hstep, voffB);
            PG8_WAIT_V(6); PG8_BAR; PG8_MMA(1, 1, At, B1); PG8_BAR;
            PG8_LDB(B0, 1, 0); PG8_SCHED; PG8_LDA(At, 1, 0); PG8_STAGE(PG8_SA(0, 1), a2 + hstep, voffA);
            PG8_WAIT_L(8); PG8_BAR; PG8_WAIT_L(0); PG8_MMA(0, 0, At, B0); PG8_BAR; PG8_SCHED;
            PG8_LDB(B1, 1, 1); PG8_STAGE(PG8_SB(1, 0), b3, voffB);
            PG8_BAR; PG8_WAIT_L(0); PG8_MMA(0, 1, At, B1); PG8_BAR;
            PG8_LDA(At, 1, 1); PG8_STAGE(PG8_SA(1, 0), a3, voffA);
            PG8_BAR; PG8_WAIT_L(0); PG8_MMA(1, 0, At, B0); PG8_BAR; PG8_SCHED;
            PG8_STAGE(PG8_SB(1, 1), b3 + hstep, voffB);
            PG8_WAIT_V(6); PG8_BAR; PG8_MMA(1, 1, At, B1); PG8_BAR;
            }
        }
        if constexpr (ALIGN_EPI) { if (wr == 0) PG8_BAR; }
        if constexpr (!Epi::AFTER_DRAIN) { E(acc, cur, wr, wc, fr, fq); S.done(cur); }
        if (!has_next) break;
#pragma unroll
        for (int a = 0; a < 2; ++a)
#pragma unroll
            for (int b = 0; b < 2; ++b)
#pragma unroll
                for (int m = 0; m < 4; ++m)
#pragma unroll
                    for (int n = 0; n < 2; ++n) acc[a][b][m][n] = (f32x4){0.f, 0.f, 0.f, 0.f};
        cur = nxt; cA = nA; cB = nB; ++ui;
        PG8_GV(gv, cur);
        if constexpr (ALIGN_EPI) { if (wr == 1) PG8_BAR; }
    }
    PG8_WAIT_V(0);
    if constexpr (!ALIGN_EPI) { if (wr == 0) PG8_BAR; }
    PG8_BAR;
    if constexpr (Epi::AFTER_DRAIN) { E.fused(acc, cur, wr, wc, fr, fq, lds, wid, lane); S.done(cur); }
#undef PG8_SA
#undef PG8_SB
#undef PG8_STAGE
#undef PG8_LDA
#undef PG8_STA
#undef PG8_GV
#undef PG8_LDB
#undef PG8_MMA
#undef PG8_WAIT_V
#undef PG8_WAIT_L
#undef PG8_BAR
#undef PG8_SCHED
}
}

namespace att {
using bf16 = bf16_t;
constexpr int   D = 128, NW = 8, QBLK = 32, KVBLK = 64;
constexpr float SCALE = 0.125f;
constexpr float THR = 8.f;
constexpr int SDEPTH = 2;
constexpr int LDQ = ABIN, LDK = ABIN, LDO = 2 * NDH * VD;
constexpr size_t SHM_V = KVBLK * D * 2, SHM_K = KVBLK * D * 2, SHM_ATTN = 2 * SHM_V + 2 * SHM_K + NW * 64 * 4;
using bf16x8 = __attribute__((ext_vector_type(8))) short;
using s16x4  = __attribute__((ext_vector_type(4))) short;
using f32x16 = __attribute__((ext_vector_type(16))) float;
using f32x8  = __attribute__((ext_vector_type(8))) float;
using u32x4  = __attribute__((ext_vector_type(4))) unsigned;
#define KSWZ(row, colB) ((row) * 256 + ((colB) ^ (((row) & 7) << 4)))
#define SBAR() __builtin_amdgcn_sched_barrier(0)
__device__ __forceinline__ int crow(int r, int hi) { return (r & 3) + 8 * (r >> 2) + 4 * hi; }
__device__ __forceinline__ unsigned cvtpk(float lo, float hi) {
  unsigned r; asm volatile("v_cvt_pk_bf16_f32 %0, %1, %2" : "=v"(r) : "v"(lo), "v"(hi)); return r;
}
struct St { using T = bf16x8;
  __device__ static __forceinline__ T ld8(const bf16* p) { return *reinterpret_cast<const bf16x8*>(p); }
  __device__ static __forceinline__ bf16x8 tobf(T x) { return x; } };

__device__ __forceinline__ void partialSM(f32x16& p0, f32x16& p1, float& m_reg, float& mn, float& alpha) {
  constexpr float C = SCALE * 1.4426950408889634f;
  float pmax = p0[0]; for (int r = 1; r < 16; ++r) pmax = fmaxf(pmax, p0[r]); for (int r = 0; r < 16; ++r) pmax = fmaxf(pmax, p1[r]);
  { auto rr = __builtin_amdgcn_permlane32_swap(__float_as_uint(pmax), __float_as_uint(pmax), false, false);
    pmax = fmaxf(__uint_as_float(rr[0]), __uint_as_float(rr[1])); }
  if (__builtin_expect(__all(pmax - m_reg <= THR / SCALE), 1)) { mn = m_reg; alpha = 1.f; }
  else { mn = fmaxf(m_reg, pmax); alpha = __builtin_amdgcn_exp2f((m_reg - mn) * C); m_reg = mn; }
  float mnC = -mn * C;
  for (int r = 0; r < 16; ++r) p0[r] = fmaf(p0[r], C, mnC); for (int r = 0; r < 16; ++r) p1[r] = fmaf(p1[r], C, mnC);
  for (int r = 0; r < 16; ++r) p0[r] = __builtin_amdgcn_exp2f(p0[r]);
}
__device__ __forceinline__ void finishSM(f32x16& p0, f32x16& p1, float alpha, float& l_reg, bf16x8& pa0, bf16x8& pa1, bf16x8& pa2, bf16x8& pa3) {
  for (int r = 0; r < 16; ++r) p1[r] = __builtin_amdgcn_exp2f(p1[r]);
  float ps = 0; for (int r = 0; r < 16; ++r) ps += p0[r]; for (int r = 0; r < 16; ++r) ps += p1[r];
  { auto rr = __builtin_amdgcn_permlane32_swap(__float_as_uint(ps), __float_as_uint(ps), false, false);
    ps = __uint_as_float(rr[0]) + __uint_as_float(rr[1]); }
  l_reg = l_reg * alpha + ps;
#define PK4(P, BASE, OUT) do { unsigned a0 = cvtpk(P[BASE + 0], P[BASE + 1]), a1 = cvtpk(P[BASE + 2], P[BASE + 3]);   \
    unsigned b0 = cvtpk(P[BASE + 4], P[BASE + 5]), b1 = cvtpk(P[BASE + 6], P[BASE + 7]);                              \
    auto r0 = __builtin_amdgcn_permlane32_swap(a0, b0, false, false); auto r1 = __builtin_amdgcn_permlane32_swap(a1, b1, false, false); \
    u32x4 w = {r0[0], r1[0], r0[1], r1[1]}; OUT = *reinterpret_cast<bf16x8*>(&w); } while (0)
  PK4(p0, 0, pa0); PK4(p0, 8, pa1); PK4(p1, 0, pa2); PK4(p1, 8, pa3);
#undef PK4
}
__device__ __forceinline__ void qkt(f32x16& p0, f32x16& p1, const bf16* Ks, const bf16x8* qr, int r32, int hi, int cbase) {
  p0 = f32x16{}; p1 = f32x16{};
#pragma unroll
  for (int d0 = 0; d0 < 4; ++d0) { int cb = cbase + (d0 * 16 + hi * 8) * 2;
    bf16x8 b0 = *reinterpret_cast<const bf16x8*>((const char*)Ks + KSWZ(r32, cb));
    bf16x8 b1 = *reinterpret_cast<const bf16x8*>((const char*)Ks + KSWZ(32 + r32, cb));
    p0 = __builtin_amdgcn_mfma_f32_32x32x16_bf16(b0, qr[d0], p0, 0, 0, 0);
    p1 = __builtin_amdgcn_mfma_f32_32x32x16_bf16(b1, qr[d0], p1, 0, 0, 0); }
}
__device__ __forceinline__ int v_st(int k, int c) { const int kk = (k & ~0xC) | ((k & 4) << 1) | ((k & 8) >> 1); return ((kk >> 3) * 4 + (c >> 5)) * 512 + ((kk & 7) * 32 + (c & 31)) * 2; }
__device__ __forceinline__ int v_rd_base(int lane) { return ((lane & 3) << 3) | (((lane >> 2) & 3) << 6) | (((lane >> 4) & 1) << 5) | (((lane >> 5) & 1) << 8); }
constexpr int v_rd_off(int d0, int ks, int half) { return d0 * 512 + ks * 4096 + half * 2048; }
template <int OFF> __device__ __forceinline__ s16x4 tr_read(int vb) {
  s16x4 r; asm volatile("ds_read_b64_tr_b16 %0, %1 offset:%2" : "=&v"(r) : "v"(vb), "i"(OFF) : "memory"); return r;
}
template <int D0> __device__ __forceinline__ void pv_one(f32x16& od, int vb, bf16x8 pa0, bf16x8 pa1, bf16x8 pa2, bf16x8 pa3) {
  const s16x4 l0 = tr_read<v_rd_off(D0, 0, 0)>(vb), h0 = tr_read<v_rd_off(D0, 0, 1)>(vb), l1 = tr_read<v_rd_off(D0, 1, 0)>(vb), h1 = tr_read<v_rd_off(D0, 1, 1)>(vb);
  const s16x4 l2 = tr_read<v_rd_off(D0, 2, 0)>(vb), h2 = tr_read<v_rd_off(D0, 2, 1)>(vb), l3 = tr_read<v_rd_off(D0, 3, 0)>(vb), h3 = tr_read<v_rd_off(D0, 3, 1)>(vb);
  asm volatile("s_waitcnt lgkmcnt(0)" ::: "memory"); SBAR();
#define PK(L, H) (bf16x8){L[0], L[1], L[2], L[3], H[0], H[1], H[2], H[3]}
  od = __builtin_amdgcn_mfma_f32_32x32x16_bf16(pa0, PK(l0, h0), od, 0, 0, 0);
  od = __builtin_amdgcn_mfma_f32_32x32x16_bf16(pa1, PK(l1, h1), od, 0, 0, 0);
  od = __builtin_amdgcn_mfma_f32_32x32x16_bf16(pa2, PK(l2, h2), od, 0, 0, 0);
  od = __builtin_amdgcn_mfma_f32_32x32x16_bf16(pa3, PK(l3, h3), od, 0, 0, 0);
#undef PK
}
__device__ __forceinline__ void pv_d0(f32x16* o, int vb, bf16x8 pa0, bf16x8 pa1, bf16x8 pa2, bf16x8 pa3) {
  pv_one<0>(o[0], vb, pa0, pa1, pa2, pa3); pv_one<1>(o[1], vb, pa0, pa1, pa2, pa3); pv_one<2>(o[2], vb, pa0, pa1, pa2, pa3); pv_one<3>(o[3], vb, pa0, pa1, pa2, pa3);
}

__device__ __forceinline__ void attn_dense_body(const bf16* __restrict__ Qb, const bf16* __restrict__ Kh, const bf16* __restrict__ Vh,
                                                float* __restrict__ Ob, int seq, char* lds, int cbase) {
  using SQ = St;
  int tid_ = threadIdx.x; asm volatile("" : "+v"(tid_));
  const int tid = tid_, wid = tid >> 6, lane = tid & 63, r32 = lane & 31, hi = lane >> 5;
  bf16* V_lds = (bf16*)lds; bf16* K_lds = (bf16*)(lds + 2 * SHM_V);
  float* ws = (float*)(lds + 2 * SHM_V + 2 * SHM_K) + wid * 64; float* li_l = ws; float* al_l = ws + 32;
  float m_reg = -1e30f, l_reg = 0; f32x16 o[4] = {}; bf16x8 qr[4];
  const bf16* Qw = Qb + (long)(wid * QBLK + r32) * LDQ + hi * 8;
#pragma unroll
  for (int d0 = 0; d0 < 4; ++d0) qr[d0] = SQ::tobf(SQ::ld8(Qw + d0 * 16));
  const int sr = tid >> 4, sc = (tid & 15) * 8, vst0 = v_st(sr, sc), vst1 = v_st(32 + sr, sc);
  const int vb0 = (int)(uintptr_t)V_lds + v_rd_base(lane);
  struct { typename St::T vs0, vs1, ks0, ks1; } sr_[SDEPTH];
  const unsigned so0 = (unsigned)(sr * LDK + sc) * 2u;
#define SLOAD(i, k0) do { const unsigned o0_ = so0 + (unsigned)(k0) * (unsigned)(LDK * 2), o1_ = o0_ + 32u * LDK * 2u; \
    sr_[i].vs0 = St::ld8((const bf16*)((const char*)Vh + o0_)); sr_[i].vs1 = St::ld8((const bf16*)((const char*)Vh + o1_)); \
    sr_[i].ks0 = St::ld8((const bf16*)((const char*)Kh + o0_)); sr_[i].ks1 = St::ld8((const bf16*)((const char*)Kh + o1_)); } while (0)
#define SWRITE(b, i) do { *(bf16x8*)((char*)V_lds + (b) * SHM_V + vst0) = St::tobf(sr_[i].vs0);          \
    *(bf16x8*)((char*)V_lds + (b) * SHM_V + vst1) = St::tobf(sr_[i].vs1); int kc = sc * 2;               \
    *(bf16x8*)((char*)K_lds + (b) * SHM_K + KSWZ(sr, kc)) = St::tobf(sr_[i].ks0);                       \
    *(bf16x8*)((char*)K_lds + (b) * SHM_K + KSWZ(32 + sr, kc)) = St::tobf(sr_[i].ks1); } while (0)
#define SWAIT() do { if constexpr (SDEPTH == 2) asm volatile("s_waitcnt vmcnt(4)" ::: "memory"); else asm volatile("s_waitcnt vmcnt(0)" ::: "memory"); } while (0)
#define RESC(a) do { if (__any((a) < 1.f)) { if (hi == 0) al_l[r32] = (a); asm volatile("s_waitcnt lgkmcnt(0)" ::: "memory"); \
    for (int d = 0; d < 4; ++d) for (int r = 0; r < 16; ++r) o[d][r] *= al_l[crow(r, hi)]; } } while (0)
  f32x16 pA0, pA1, pB0, pB1; float mnA, mnB, alA, alB; bf16x8 pa0, pa1, pa2, pa3; const int NT = seq / KVBLK;
  constexpr int SE = 0, SO = SDEPTH - 1;
  SLOAD(SE, 0); asm volatile("s_waitcnt vmcnt(0)" ::: "memory"); SWRITE(0, SE); __syncthreads();
  qkt(pA0, pA1, K_lds, qr, r32, hi, cbase); partialSM(pA0, pA1, m_reg, mnA, alA);
  SLOAD(SO, KVBLK); if constexpr (SDEPTH == 2) { if (2 < NT) SLOAD(SE, 2 * KVBLK); }
  SWAIT(); SWRITE(1, SO); __syncthreads();
  for (int j = 1; j + 1 < NT; j += 2) {
    SBAR(); qkt(pB0, pB1, (bf16*)((char*)K_lds + SHM_K), qr, r32, hi, cbase);
    finishSM(pA0, pA1, alA, l_reg, pa0, pa1, pa2, pa3); SBAR();
    SLOAD(SO, (j + SDEPTH) * KVBLK); SBAR();
    pv_d0(o, vb0, pa0, pa1, pa2, pa3); partialSM(pB0, pB1, m_reg, mnB, alB);
    __syncthreads(); SWAIT(); SWRITE(0, SE);
    RESC(alB); __syncthreads();
    SBAR(); qkt(pA0, pA1, K_lds, qr, r32, hi, cbase);
    finishSM(pB0, pB1, alB, l_reg, pa0, pa1, pa2, pa3); SBAR();
    if (SDEPTH == 1 || j + 3 < NT) SLOAD(SE, (j + 1 + SDEPTH) * KVBLK); SBAR();
    pv_d0(o, vb0 + (int)SHM_V, pa0, pa1, pa2, pa3); partialSM(pA0, pA1, m_reg, mnA, alA);
    __syncthreads(); SWAIT(); SWRITE(1, SO);
    RESC(alA); __syncthreads();
  }
  SBAR(); qkt(pB0, pB1, (bf16*)((char*)K_lds + SHM_K), qr, r32, hi, cbase);
  finishSM(pA0, pA1, alA, l_reg, pa0, pa1, pa2, pa3); SBAR();
  pv_d0(o, vb0, pa0, pa1, pa2, pa3); partialSM(pB0, pB1, m_reg, mnB, alB);
  __syncthreads(); RESC(alB);
  finishSM(pB0, pB1, alB, l_reg, pa0, pa1, pa2, pa3); SBAR();
  pv_d0(o, vb0 + (int)SHM_V, pa0, pa1, pa2, pa3);
  if (hi == 0) li_l[r32] = l_reg; asm volatile("s_waitcnt lgkmcnt(0)" ::: "memory");
  float rli[16];
#pragma unroll
  for (int r = 0; r < 16; ++r) rli[r] = __builtin_amdgcn_rcpf(li_l[crow(r, hi)]);
  float* Ow = Ob + (long)(wid * QBLK) * LDO;
#pragma unroll
  for (int r = 0; r < 16; ++r) { int orow = crow(r, hi);
    for (int d0 = 0; d0 < 4; ++d0) Ow[(long)orow * LDO + d0 * 32 + r32] = o[d0][r] * rli[r]; }
#undef SLOAD
#undef SWRITE
#undef SWAIT
#undef RESC
}


__device__ __forceinline__ void attn_combine(const float* O1, const float* O2, float lam, float nscale, const float* __restrict__ sg, bf16* __restrict__ Cb, int ldc) {
  int tid_ = threadIdx.x; asm volatile("" : "+v"(tid_));
  const int wid = tid_ >> 6, lane = tid_ & 63, r32 = lane & 31, hi = lane >> 5;
  const float* W1 = O1 + (long)(wid * QBLK) * LDO; const float* W2 = O2 + (long)(wid * QBLK) * LDO; bf16* Cw = Cb + (long)(wid * QBLK) * ldc;
  float sgv[4];
#pragma unroll
  for (int d0 = 0; d0 < 4; ++d0) sgv[d0] = sg[d0 * 32 + r32] * nscale;
#pragma unroll 4
  for (int r = 0; r < 16; ++r) { const int orow = crow(r, hi); float v[4]; float ss = 0.f;
#pragma unroll
    for (int d0 = 0; d0 < 4; ++d0) { v[d0] = W1[(long)orow * LDO + d0 * 32 + r32] - lam * W2[(long)orow * LDO + d0 * 32 + r32]; ss += v[d0] * v[d0]; }
#pragma unroll
    for (int x = 1; x < 32; x <<= 1) ss += __shfl_xor(ss, x);
    const float rs = 1.f / sqrtf(ss * (1.f / 128.f) + 1e-6f);
#pragma unroll
    for (int d0 = 0; d0 < 4; ++d0) { const float q = v[d0] * rs * sgv[d0]; Cw[(long)orow * ldc + d0 * 32 + r32] = (bf16)cvtpk(q, q); } }
}

}

namespace ssd {
using att::bf16x8; using att::f32x16; using att::cvtpk; using att::crow;
typedef short s16x4 __attribute__((ext_vector_type(4)));
constexpr int CH = 128, NC = TPB / CH;
constexpr int IMG_B = 0, IMG_C = 32768, IMG_X = 65536, IMG_S = 98304, ARR = 114688, ARR_STRIDE = 4096, PART = 122880;
constexpr int SSD_LDS_END = PART + 16384;
constexpr float LOG2E = 1.4426950408889634f;
__device__ __forceinline__ unsigned offb(unsigned row, unsigned ch) { return 256u * row + 16u * (ch ^ (((row & 3u) << 2) | ((row >> 2) & 3u))); }
__device__ __forceinline__ unsigned row_addr(unsigned lane, unsigned rb, unsigned s) { return offb(32u * rb + (lane & 31u), 2u * s + (lane >> 5)); }
__device__ __forceinline__ unsigned tr_addr(unsigned lane, unsigned c, unsigned ks, unsigned t) {
    const unsigned h = lane >> 5, blk = (lane >> 4) & 1u, q = (lane & 15u) >> 2, pp = lane & 3u;
    return offb(16u * ks + 8u * h + 4u * t + q, 4u * c + 2u * blk + (pp >> 1)) + 8u * (pp & 1u);
}
__device__ __forceinline__ s16x4 tr_rd(unsigned a) { s16x4 r; asm volatile("ds_read_b64_tr_b16 %0, %1" : "=v"(r) : "v"(a) : "memory"); return r; }
template <int OFF> __device__ __forceinline__ s16x4 tr_rdo(unsigned a) { s16x4 r; asm volatile("ds_read_b64_tr_b16 %0, %1 offset:%2" : "=v"(r) : "v"(a), "i"(OFF) : "memory"); return r; }
__device__ __forceinline__ unsigned row_base(unsigned lane) { return row_addr(lane, 0, 0); }
__device__ __forceinline__ unsigned tr_base(unsigned lane, unsigned t) { return tr_addr(lane, 0, 0, t); }
__device__ __forceinline__ int tok_of(int dir, int q) { const int fl = (q < CTX ? CTX - 1 : TPB + CTX - 1) - q; return dir ? fl : q; }
#define SSD_PK4(P, BASE, OUT) do { unsigned a0 = cvtpk(P[BASE + 0], P[BASE + 1]), a1 = cvtpk(P[BASE + 2], P[BASE + 3]);   \
    unsigned b0 = cvtpk(P[BASE + 4], P[BASE + 5]), b1 = cvtpk(P[BASE + 6], P[BASE + 7]);                              \
    auto r0 = __builtin_amdgcn_permlane32_swap(a0, b0, false, false); auto r1 = __builtin_amdgcn_permlane32_swap(a1, b1, false, false); \
    att::u32x4 w = {r0[0], r1[0], r0[1], r1[1]}; OUT = *reinterpret_cast<bf16x8*>(&w); } while (0)

__device__ __forceinline__ void ssd_unit(const Prm& p, int ih, int b, int dir, int h, LAS unsigned char* lds) {
    int tid_ = threadIdx.x; asm volatile("" : "+v"(tid_));
    const int tid = tid_, wave = __builtin_amdgcn_readfirstlane(tid >> 6), lane = tid & 63, r32 = lane & 31, hi = lane >> 5;
    const int g = h / SSD_E;
    const float A2 = -expf(p.in[I_SSDALOG][(size_t)ih * 2 * SSD_H + dir * SSD_H + h]) * LOG2E;
    const char* XBCb = (const char*)WSP(const bf16_t, WS_XBC); const float* DT = WSP(const float, WS_DT);
    char* Yb = (char*)(WSP(bf16_t, WS_YS) + (size_t)dir * R * SSD_DI);
    const unsigned L = (unsigned)(uintptr_t)lds;
    const int rowb = b * TPB, sgn = dir ? -1 : 1;
    const int sB = tid >> 4, sX = tid >> 3;
    const unsigned gB0 = (unsigned)(rowb + sgn * sB) * (unsigned)(SSD_CC * 2) + (unsigned)((SSD_DI + g * SSD_N + (tid & 15) * 8) * 2);
    const unsigned gX0 = (unsigned)(rowb + sgn * sX) * (unsigned)(SSD_CC * 2) + (unsigned)((h * SSD_P + (tid & 7) * 8) * 2);
    const int gstepB = sgn * 32 * SSD_CC * 2, gstepX = sgn * 64 * SSD_CC * 2;
    const unsigned wB0 = offb(sB, tid & 15), wX0 = offb(sX, tid & 7), wXW0 = offb(sX, 8 + (tid & 7));
    att::u32x4 rB[4], rC[4], rX[2];
#define SSD_LOAD(c) do { const unsigned t0_ = (unsigned)(tok_of(dir, (c) * CH) * (SSD_CC * 2)); \
        _Pragma("unroll") for (int i = 0; i < 4; ++i) { const unsigned o_ = gB0 + t0_ + (unsigned)(i * gstepB); rB[i] = *(const att::u32x4*)(XBCb + o_); rC[i] = *(const att::u32x4*)(XBCb + o_ + SSD_G * SSD_N * 2); } \
        _Pragma("unroll") for (int i = 0; i < 2; ++i) { const unsigned o_ = gX0 + t0_ + (unsigned)(i * gstepX); rX[i] = *(const att::u32x4*)(XBCb + o_); } } while (0)
#define SSD_WRITE(c) do { const LAS float* wv_ = (const LAS float*)(lds + ARR + ((c) & 1) * ARR_STRIDE) + 256; \
        _Pragma("unroll") for (int i = 0; i < 4; ++i) { *(LAS att::u32x4*)(lds + IMG_B + wB0 + 8192 * i) = rB[i]; *(LAS att::u32x4*)(lds + IMG_C + wB0 + 8192 * i) = rC[i]; } \
        _Pragma("unroll") for (int i = 0; i < 2; ++i) { *(LAS att::u32x4*)(lds + IMG_X + wX0 + 16384 * i) = rX[i]; const float w_ = wv_[sX + 64 * i]; \
            att::u32x4 q_; q_.x = cvtpk(__uint_as_float(rX[i].x << 16) * w_, __uint_as_float(rX[i].x & 0xffff0000u) * w_); q_.y = cvtpk(__uint_as_float(rX[i].y << 16) * w_, __uint_as_float(rX[i].y & 0xffff0000u) * w_); \
            q_.z = cvtpk(__uint_as_float(rX[i].z << 16) * w_, __uint_as_float(rX[i].z & 0xffff0000u) * w_); q_.w = cvtpk(__uint_as_float(rX[i].w << 16) * w_, __uint_as_float(rX[i].w & 0xffff0000u) * w_); \
            *(LAS att::u32x4*)(lds + IMG_X + wXW0 + 16384 * i) = q_; } } while (0)
    float sd0 = 0.f, sd1 = 0.f;
#define SSD_DTLOAD(c) do { if (wave == 0) { const int t0_ = rowb + tok_of(dir, (c) * CH); sd0 = DT[(size_t)(t0_ + sgn * (2 * lane)) * 2 * SSD_H + dir * SSD_H + h]; sd1 = DT[(size_t)(t0_ + sgn * (2 * lane + 1)) * 2 * SSD_H + dir * SSD_H + h]; } } while (0)
#define SSD_SCAN(c) do { if (wave == 0) { LAS float* ar = (LAS float*)(lds + ARR + ((c) & 1) * ARR_STRIDE); const float d0 = sd0, d1 = sd1; \
            const float a0 = d0 * A2, a1 = d1 * A2; float v = a0 + a1; \
            _Pragma("unroll") for (int o = 1; o < 64; o <<= 1) { const float tq = __shfl_up(v, o); if (lane >= o) v += tq; } \
            const float tot = __shfl(v, 63), c1 = v, c0 = v - a1; \
            ar[2 * lane] = c0; ar[2 * lane + 1] = c1; ar[128 + 2 * lane] = c0 - __builtin_amdgcn_logf(d0); ar[128 + 2 * lane + 1] = c1 - __builtin_amdgcn_logf(d1); \
            ar[256 + 2 * lane] = d0 * __builtin_amdgcn_exp2f(tot - c0); ar[256 + 2 * lane + 1] = d1 * __builtin_amdgcn_exp2f(tot - c1); \
            ar[384 + 2 * lane] = __builtin_amdgcn_exp2f(c0); ar[384 + 2 * lane + 1] = __builtin_amdgcn_exp2f(c1); if (lane == 0) ar[512] = __builtin_amdgcn_exp2f(tot); } } while (0)

    const bool isB = wave >= 4; const int lb = isB ? 7 - wave : wave, pb = wave >> 2, nb = wave & 3;
    const unsigned ra0 = L + row_base(lane);
    const unsigned tb0 = L + tr_base(lane, 0), tb1 = L + tr_base(lane, 1);
    const unsigned vx00 = IMG_X + tb0, vx01 = IMG_X + tb1, vx10 = IMG_X + (tb0 ^ 64u), vx11 = IMG_X + (tb1 ^ 64u);
    const unsigned vw0 = IMG_X + (tb0 ^ (64u * (2 + pb))), vw1 = IMG_X + (tb1 ^ (64u * (2 + pb)));
    const unsigned vb0 = IMG_B + (tb0 ^ (64u * nb)), vb1 = IMG_B + (tb1 ^ (64u * nb));
    const unsigned sw0 = IMG_S + 8192u * pb + 1024u * hi + 16u * ((unsigned)(4 * nb + (r32 >> 3)) ^ (unsigned)hi) + 2u * (r32 & 7);
    const unsigned yo0 = (unsigned)((rowb + sgn * (32 * lb + 4 * hi)) * SSD_DI + h * SSD_P + r32) * 2u;
    const int ystep = sgn * SSD_DI * 2;
    unsigned rak[8];
#pragma unroll
    for (int kn = 0; kn < 8; ++kn) rak[kn] = ra0 ^ (32u * kn);
#define SSD_ROWRD(img, rb, kn) (*(const LAS bf16x8*)(uintptr_t)(rak[kn] + (unsigned)(img) + 8192u * (unsigned)(rb)))
    f32x16 S = {};
    *(LAS att::u32x4*)(lds + IMG_S + tid * 16) = (att::u32x4){0u, 0u, 0u, 0u}; *(LAS att::u32x4*)(lds + IMG_S + 8192 + tid * 16) = (att::u32x4){0u, 0u, 0u, 0u};
    SSD_LOAD(0); SSD_DTLOAD(0); SSD_SCAN(0);
    __syncthreads();
    SSD_WRITE(0);
    __syncthreads();
#pragma unroll 1
    for (int c = 0; c < NC; ++c) {
        if (c + 1 < NC) { SSD_LOAD(c + 1); SSD_DTLOAD(c + 1); }
        const LAS float* arr = (const LAS float*)(lds + ARR + (c & 1) * ARR_STRIDE);
        f32x16 yd0 = {}, yd1 = {};
        bf16x8 cf[8];
#pragma unroll
        for (int kn = 0; kn < 8; ++kn) cf[kn] = SSD_ROWRD(IMG_C, lb, kn);
        const float csl = arr[32 * lb + r32];
#pragma unroll 1
        for (int sb = lb - (isB ? 1 : 0); sb >= 0; sb -= 2) {
            f32x16 G = {};
#pragma unroll
            for (int kn = 0; kn < 8; ++kn) { const bf16x8 bf = SSD_ROWRD(IMG_B, sb, kn); G = __builtin_amdgcn_mfma_f32_32x32x16_bf16(bf, cf[kn], G, 0, 0, 0); }
            const s16x4 x00 = tr_rd(vx00 + 8192u * sb), x01 = tr_rd(vx01 + 8192u * sb), x02 = tr_rdo<4096>(vx00 + 8192u * sb), x03 = tr_rdo<4096>(vx01 + 8192u * sb);
            const s16x4 x10 = tr_rd(vx10 + 8192u * sb), x11 = tr_rd(vx11 + 8192u * sb), x12 = tr_rdo<4096>(vx10 + 8192u * sb), x13 = tr_rdo<4096>(vx11 + 8192u * sb);
#pragma unroll
            for (int q = 0; q < 4; ++q) { const pg8::f32x4 u4 = *(const LAS pg8::f32x4*)(arr + 128 + 32 * sb + 8 * q + 4 * hi);
#pragma unroll
                for (int i = 0; i < 4; ++i) G[4 * q + i] *= __builtin_amdgcn_exp2f(csl - u4[i]); }
            if (sb == lb) {
#pragma unroll
                for (int q = 0; q < 4; ++q)
#pragma unroll
                    for (int i = 0; i < 4; ++i) G[4 * q + i] = (8 * q + 4 * hi + i > r32) ? 0.f : G[4 * q + i];
            }
            bf16x8 pa0, pa1; SSD_PK4(G, 0, pa0); SSD_PK4(G, 8, pa1);
            asm volatile("s_waitcnt lgkmcnt(0)" ::: "memory"); __builtin_amdgcn_sched_barrier(0);
            yd0 = __builtin_amdgcn_mfma_f32_32x32x16_bf16(pa0, (bf16x8){x00[0], x00[1], x00[2], x00[3], x01[0], x01[1], x01[2], x01[3]}, yd0, 0, 0, 0);
            yd1 = __builtin_amdgcn_mfma_f32_32x32x16_bf16(pa0, (bf16x8){x10[0], x10[1], x10[2], x10[3], x11[0], x11[1], x11[2], x11[3]}, yd1, 0, 0, 0);
            yd0 = __builtin_amdgcn_mfma_f32_32x32x16_bf16(pa1, (bf16x8){x02[0], x02[1], x02[2], x02[3], x03[0], x03[1], x03[2], x03[3]}, yd0, 0, 0, 0);
            yd1 = __builtin_amdgcn_mfma_f32_32x32x16_bf16(pa1, (bf16x8){x12[0], x12[1], x12[2], x12[3], x13[0], x13[1], x13[2], x13[3]}, yd1, 0, 0, 0);
        }
        if (isB) {
            f32x16 yf0 = {}, yf1 = {};
#pragma unroll
            for (int kn = 0; kn < 8; ++kn) { const bf16x8 s0 = SSD_ROWRD(IMG_S, 0, kn), s1 = SSD_ROWRD(IMG_S, 1, kn);
                yf0 = __builtin_amdgcn_mfma_f32_32x32x16_bf16(cf[kn], s0, yf0, 0, 0, 0); yf1 = __builtin_amdgcn_mfma_f32_32x32x16_bf16(cf[kn], s1, yf1, 0, 0, 0); }
#pragma unroll
            for (int q = 0; q < 4; ++q) { const pg8::f32x4 e4 = *(const LAS pg8::f32x4*)(arr + 384 + 32 * lb + 8 * q + 4 * hi);
                att::u32x4 w;
                w.x = cvtpk(yd0[4 * q] + e4[0] * yf0[4 * q], yd0[4 * q + 1] + e4[1] * yf0[4 * q + 1]); w.y = cvtpk(yd0[4 * q + 2] + e4[2] * yf0[4 * q + 2], yd0[4 * q + 3] + e4[3] * yf0[4 * q + 3]);
                w.z = cvtpk(yd1[4 * q] + e4[0] * yf1[4 * q], yd1[4 * q + 1] + e4[1] * yf1[4 * q + 1]); w.w = cvtpk(yd1[4 * q + 2] + e4[2] * yf1[4 * q + 2], yd1[4 * q + 3] + e4[3] * yf1[4 * q + 3]);
                *(LAS att::u32x4*)(lds + PART + lb * 4096 + q * 1024 + lane * 16) = w; }
        }
        { const float dec = arr[512];
#pragma unroll
          for (int r = 0; r < 16; ++r) S[r] *= dec; }
        {
            s16x4 xa[8][2], bb[8][2];
#pragma unroll
            for (int ks = 0; ks < 8; ++ks) { xa[ks][0] = tr_rd(vw0 + 4096u * ks); xa[ks][1] = tr_rd(vw1 + 4096u * ks); bb[ks][0] = tr_rd(vb0 + 4096u * ks); bb[ks][1] = tr_rd(vb1 + 4096u * ks); }
            asm volatile("s_waitcnt lgkmcnt(0)" ::: "memory"); __builtin_amdgcn_sched_barrier(0);
#pragma unroll
            for (int ks = 0; ks < 8; ++ks)
                S = __builtin_amdgcn_mfma_f32_32x32x16_bf16((bf16x8){xa[ks][0][0], xa[ks][0][1], xa[ks][0][2], xa[ks][0][3], xa[ks][1][0], xa[ks][1][1], xa[ks][1][2], xa[ks][1][3]},
                                                           (bf16x8){bb[ks][0][0], bb[ks][0][1], bb[ks][0][2], bb[ks][0][3], bb[ks][1][0], bb[ks][1][1], bb[ks][1][2], bb[ks][1][3]}, S, 0, 0, 0);
        }
        if (c + 1 < NC) SSD_SCAN(c + 1);
        __syncthreads();
        if (!isB) { const unsigned yo = yo0 + (unsigned)(tok_of(dir, c * CH) * (SSD_DI * 2));
#pragma unroll
            for (int q = 0; q < 4; ++q) { const att::u32x4 w = *(const LAS att::u32x4*)(lds + PART + lb * 4096 + q * 1024 + lane * 16);
                const float p0[4] = {__uint_as_float(w.x << 16), __uint_as_float(w.x & 0xffff0000u), __uint_as_float(w.y << 16), __uint_as_float(w.y & 0xffff0000u)};
                const float p1[4] = {__uint_as_float(w.z << 16), __uint_as_float(w.z & 0xffff0000u), __uint_as_float(w.w << 16), __uint_as_float(w.w & 0xffff0000u)};
#pragma unroll
                for (int i = 0; i < 4; ++i) { const float v0 = yd0[4 * q + i] + p0[i], v1 = yd1[4 * q + i] + p1[i]; char* yp = Yb + (yo + (unsigned)((8 * q + i) * ystep));
                    *(bf16_t*)yp = (bf16_t)cvtpk(v0, v0); *(bf16_t*)(yp + 64) = (bf16_t)cvtpk(v1, v1); } } }
#pragma unroll
        for (int r = 0; r < 16; ++r) { constexpr int dummy = 0; (void)dummy; const unsigned xr = (unsigned)(((r & 3) << 2) | ((2 * (r >> 2)) & 2));
            *(LAS bf16_t*)(lds + ((sw0 ^ (16u * xr)) + 256u * (unsigned)((r & 3) + 8 * (r >> 2)))) = (bf16_t)cvtpk(S[r], S[r]); }
        if (c + 1 < NC) SSD_WRITE(c + 1);
        __syncthreads();
    }
#undef SSD_ROWRD
#undef SSD_LOAD
#undef SSD_WRITE
#undef SSD_SCAN
#undef SSD_DTLOAD
}
}

constexpr int NTHR = 512;
constexpr int RING_BYTES = 147456;
constexpr int LDSCTL_OFF = RING_BYTES, MISC_OFF = LDSCTL_OFF + 320;
static_assert(ssd::SSD_LDS_END <= RING_BYTES, "SSD LDS map");
constexpr int LDS_BYTES = 163840;
constexpr int CW_BAR = 4096;

#define GAS __attribute__((address_space(1)))
typedef float f32x4_t __attribute__((ext_vector_type(4)));
typedef unsigned u32x4_t __attribute__((ext_vector_type(4)));
typedef unsigned u32x2_t __attribute__((ext_vector_type(2)));
typedef float f32x2_t __attribute__((ext_vector_type(2)));
__device__ __forceinline__ float wave_sum(float v) {
#pragma unroll
    for (int o = 1; o < 64; o <<= 1) v += __shfl_xor(v, o);
    return v;
}
__device__ __forceinline__ unsigned pk2(float lo, float hi) { unsigned r; asm volatile("v_cvt_pk_bf16_f32 %0, %1, %2" : "=v"(r) : "v"(lo), "v"(hi)); return r; }
__device__ __forceinline__ float bflo(unsigned u) { return __uint_as_float(u << 16); }
__device__ __forceinline__ float bfhi(unsigned u) { return __uint_as_float(u & 0xffff0000u); }
__device__ __forceinline__ float silu_fast(float x) { return x * __builtin_amdgcn_rcpf(1.f + __expf(-x)); }
__device__ __forceinline__ void unpack8f(u32x4_t u, float (&f)[8]) { f[0] = bflo(u.x); f[1] = bfhi(u.x); f[2] = bflo(u.y); f[3] = bfhi(u.y); f[4] = bflo(u.z); f[5] = bfhi(u.z); f[6] = bflo(u.w); f[7] = bfhi(u.w); }
__device__ __forceinline__ u32x4_t pack8f(const float (&f)[8]) { u32x4_t u; u.x = pk2(f[0], f[1]); u.y = pk2(f[2], f[3]); u.z = pk2(f[4], f[5]); u.w = pk2(f[6], f[7]); return u; }

__device__ __forceinline__ void transpose_item(const float* W, int K, int N, bf16_t* WT, int k0, int n0, int drow0, LAS float* scr, int lane) {
    f32x4_t ld[8];
#pragma unroll
    for (int i = 0; i < 8; ++i) ld[i] = *(const f32x4_t*)(W + (size_t)(k0 + 8 * i + (lane >> 3)) * N + n0 + 4 * (lane & 7));
#pragma unroll
    for (int i = 0; i < 8; ++i) { LAS float* d = scr + (8 * i + (lane >> 3)) * 33 + 4 * (lane & 7); d[0] = ld[i].x; d[1] = ld[i].y; d[2] = ld[i].z; d[3] = ld[i].w; }
    asm volatile("s_waitcnt lgkmcnt(0)" ::: "memory");
    const int c = lane & 7;
#pragma unroll
    for (int j = 0; j < 4; ++j) { const int n = (lane >> 3) + 8 * j; const LAS float* s = scr + (8 * c) * 33 + n;
        u32x4_t o; o.x = pk2(s[0 * 33], s[1 * 33]); o.y = pk2(s[2 * 33], s[3 * 33]); o.z = pk2(s[4 * 33], s[5 * 33]); o.w = pk2(s[6 * 33], s[7 * 33]);
        *(u32x4_t*)(WT + (size_t)(drow0 + n) * K + k0 + 8 * c) = o; }
    asm volatile("s_waitcnt lgkmcnt(0)" ::: "memory");
}
__device__ __forceinline__ void transpose_plain(const float* W, int K, int N, bf16_t* WT, int item, LAS float* scr, int lane) {
    const int nblk = N / 32, kb = item / nblk, nb = item % nblk;
    transpose_item(W, K, N, WT, 64 * kb, 32 * nb, 32 * nb, scr, lane);
}
struct ThinCtx { Prm p; LAS unsigned char* lds; int gw, ngw, lane, wave; };

__device__ __forceinline__ void thin_prolog_w(const ThinCtx& t) {
    const Prm& p = t.p; LAS float* scr = (LAS float*)(t.lds + t.wave * 16384);
    constexpr int I_ABIN = (DM / 64) * (ABIN / 32), I_ABOUT = (DM / 64) * (DM / 32), I_SIN = (DM / 64) * (SSD_IN / 32), I_SOUT = (SSD_DI / 64) * (DM / 32);
    constexpr int NIT = NEVEN * (I_ABIN + I_ABOUT) + NODD * (I_SIN + I_SOUT);
    for (int it = t.gw; it < NIT; it += t.ngw) {
        int r = it;
        if (r < NEVEN * I_ABIN) { const int l = r / I_ABIN; transpose_plain(p.in[I_ABWIN] + (size_t)l * DM * ABIN, DM, ABIN, WSP(bf16_t, WS_WABIN) + (size_t)l * ABIN * DM, r % I_ABIN, scr, t.lane); continue; } r -= NEVEN * I_ABIN;
        if (r < NEVEN * I_ABOUT) { const int l = r / I_ABOUT; transpose_plain(p.in[I_ABWOUT] + (size_t)l * DM * DM, DM, DM, WSP(bf16_t, WS_WABOUT) + (size_t)l * DM * DM, r % I_ABOUT, scr, t.lane); continue; } r -= NEVEN * I_ABOUT;
        if (r < NODD * I_SIN) { const int l = r / I_SIN; transpose_plain(p.in[I_SSDWIN] + (size_t)l * DM * SSD_IN, DM, SSD_IN, WSP(bf16_t, WS_WSIN) + (size_t)l * SSD_NP * DM, r % I_SIN, scr, t.lane); continue; } r -= NODD * I_SIN;
        { const int l = r / I_SOUT; transpose_plain(p.in[I_SSDWOUT] + (size_t)l * SSD_DI * DM, SSD_DI, DM, WSP(bf16_t, WS_WSOUT) + (size_t)l * DM * SSD_DI, r % I_SOUT, scr, t.lane); }
    }
    constexpr int PADV = (SSD_NP - SSD_IN) * DM / 8;
    for (int i = t.gw * 64 + t.lane; i < NODD * PADV; i += t.ngw * 64) { const int l = i / PADV, j = i % PADV;
        *(u32x4_t*)(WSP(bf16_t, WS_WSIN) + ((size_t)l * SSD_NP + SSD_IN) * DM + (size_t)j * 8) = (u32x4_t){0u, 0u, 0u, 0u}; }
}
__device__ __forceinline__ void thin_moe_w(const ThinCtx& t, int layer) {
    const Prm& p = t.p; LAS float* scr = (LAS float*)(t.lds + t.wave * 16384);
    constexpr int I_G = (DM / 64) * (MOE_HID / 32), I_D = (MOE_HID / 64) * (DM / 32), PER_E = 2 * I_G + I_D;
    for (int it = t.gw; it < MOE_E * PER_E; it += t.ngw) {
        const int e = it / PER_E; int r = it % PER_E;
        bf16_t* w1 = WSP(bf16_t, WS_W1) + (size_t)e * 2 * MOE_HID * DM;
        if (r < 2 * I_G) { const int isup = r / I_G; r %= I_G; const int nblk = MOE_HID / 32, kb = r / nblk, nb = r % nblk, n0 = 32 * nb;
            const float* src = (isup ? p.in[I_MWUP] : p.in[I_MWGATE]) + (size_t)(layer * MOE_E + e) * DM * MOE_HID;
            transpose_item(src, DM, MOE_HID, w1, 64 * kb, n0, (n0 / MOE_HB) * 2 * MOE_HB + isup * MOE_HB + (n0 % MOE_HB), scr, t.lane); continue; }
        r -= 2 * I_G;
        transpose_plain(p.in[I_MWDOWN] + (size_t)(layer * MOE_E + e) * MOE_HID * DM, MOE_HID, DM, WSP(bf16_t, WS_W2) + (size_t)e * DM * MOE_HID, r, scr, t.lane);
    }
}


__device__ __forceinline__ void thin_mods(const ThinCtx& t) {
    const Prm& p = t.p; const int lane = t.lane, wave = t.wave, tid = wave * 64 + lane;
    constexpr int CB = 6 * DM / 128;
    LAS float* sl = (LAS float*)t.lds;
    LAS float* red = sl + (NB + 1) * DM;
    __syncthreads();
    for (int i = tid; i < (NB + 1) * DM; i += NTHR) { const int j = i / DM, k = i % DM; const float v = j < NB ? p.in[I_C][j * DM + k] : p.in[I_CCTX][k]; sl[i] = v / (1.f + expf(-v)); }
    __syncthreads();
    for (int cb = blockIdx.x; cb < DEPTH * CB; cb += gridDim.x) {
        const int l = cb / CB, n0 = (cb % CB) * 128 + 2 * lane;
        const float* w = p.in[I_ADAW] + (size_t)l * DM * 6 * DM + n0;
        float acc[NB + 1][2];
#pragma unroll
        for (int j = 0; j <= NB; ++j) { acc[j][0] = 0.f; acc[j][1] = 0.f; }
        const int k0 = wave * (DM / 8);
#pragma unroll 8
        for (int k = k0; k < k0 + DM / 8; ++k) { const f32x2_t wv = *(const f32x2_t*)(w + (size_t)k * 6 * DM);
#pragma unroll
            for (int j = 0; j <= NB; ++j) { const float s = sl[j * DM + k]; acc[j][0] += s * wv.x; acc[j][1] += s * wv.y; } }
#pragma unroll
        for (int j = 0; j <= NB; ++j) *(LAS f32x2_t*)(red + (wave * (NB + 1) + j) * 128 + 2 * lane) = (f32x2_t){acc[j][0], acc[j][1]};
        __syncthreads();
        for (int i = tid; i < (NB + 1) * 128; i += NTHR) { const int j = i / 128, cn = i % 128; float s = p.in[I_ADAB][(size_t)l * 6 * DM + (cb % CB) * 128 + cn];
#pragma unroll
            for (int wv = 0; wv < 8; ++wv) s += red[(wv * (NB + 1) + j) * 128 + cn];
            WSP(float, WS_MODS)[((size_t)(l * (NB + 1) + j)) * 6 * DM + (cb % CB) * 128 + cn] = s; }
        __syncthreads();
    }
}
constexpr int NRN = 4;
template <int MODE> __device__ __forceinline__ void thin_resnorm(const ThinCtx& t, int layer) {
    const Prm& p = t.p; const int lane = t.lane;
    LAS int* offs = (LAS int*)(t.lds + MISC_OFF + 128);
    if constexpr (MODE != 0) {
        __syncthreads();
        if (threadIdx.x < 64) { const int l = threadIdx.x; const int* cnt = WSP(const int, WS_CNT) + (layer - 1) * MOE_E; const int tl = l < MOE_E ? (cnt[l] + MOE_MT - 1) / MOE_MT * MOE_MT : 0; int v = tl;
#pragma unroll
            for (int o = 1; o < 64; o <<= 1) { const int tq = __shfl_up(v, o); if (l >= o) v += tq; }
            if (l < MOE_E) offs[l] = v - tl; }
        __syncthreads();
    }
    for (int r0 = t.gw * NRN; r0 < R; r0 += t.ngw * NRN) {
        const int b = r0 / TPB, tt = r0 % TPB; const int j = tt < CTX ? NB : b;
        if (MODE == 2 && tt < CTX) continue;
        f32x4_t xv[NRN][4];
        if constexpr (MODE == 0) {
#pragma unroll
            for (int q = 0; q < NRN; ++q) { const float* src = tt < CTX ? p.in[I_CTX] + ((size_t)b * CTX + tt + q) * DM : p.in[I_X] + ((size_t)b * SEQ + (tt + q - CTX)) * DM;
#pragma unroll
                for (int c = 0; c < 4; ++c) xv[q][c] = *(const f32x4_t*)(src + c * 256 + lane * 4); }
        } else {
            float w0[NRN], w1[NRN]; int s0[NRN], s1[NRN];
#pragma unroll
            for (int q = 0; q < NRN; ++q) { const int* ro = WSP(const int, WS_ROUTE) + (size_t)(r0 + q) * 8; w0[q] = __int_as_float(ro[4]); w1[q] = __int_as_float(ro[5]); s0[q] = offs[ro[0]] + ro[2]; s1[q] = offs[ro[1]] + ro[3]; }
            const float* gate = mod_ptr(p, layer - 1, j, 5);
            f32x4_t gv[4]; u32x2_t ya[NRN][4], yb[NRN][4];
#pragma unroll
            for (int c = 0; c < 4; ++c) gv[c] = *(const f32x4_t*)(gate + c * 256 + lane * 4);
#pragma unroll
            for (int q = 0; q < NRN; ++q) { const bf16_t* xr = WSP(const bf16_t, WS_X) + (size_t)(r0 + q) * DM;
                const bf16_t* y0 = WSP(const bf16_t, WS_YB) + (size_t)s0[q] * DM; const bf16_t* y1 = WSP(const bf16_t, WS_YB) + (size_t)s1[q] * DM;
#pragma unroll
                for (int c = 0; c < 4; ++c) { const int col = c * 256 + lane * 4; const u32x2_t xb = *(const u32x2_t*)(xr + col); xv[q][c] = (f32x4_t){bflo(xb.x), bfhi(xb.x), bflo(xb.y), bfhi(xb.y)};
                    ya[q][c] = *(const u32x2_t*)(y0 + col); yb[q][c] = *(const u32x2_t*)(y1 + col); } }
#pragma unroll
            for (int q = 0; q < NRN; ++q)
#pragma unroll
                for (int c = 0; c < 4; ++c) { const u32x2_t a = ya[q][c], bq = yb[q][c];
                    f32x4_t m; m.x = w0[q] * bflo(a.x) + w1[q] * bflo(bq.x); m.y = w0[q] * bfhi(a.x) + w1[q] * bfhi(bq.x); m.z = w0[q] * bflo(a.y) + w1[q] * bflo(bq.y); m.w = w0[q] * bfhi(a.y) + w1[q] * bfhi(bq.y);
                    xv[q][c] = xv[q][c] + gv[c] * m; }
        }
        if constexpr (MODE != 2) {
#pragma unroll
            for (int q = 0; q < NRN; ++q)
#pragma unroll
                for (int c = 0; c < 4; ++c) { u32x2_t o; o.x = pk2(xv[q][c].x, xv[q][c].y); o.y = pk2(xv[q][c].z, xv[q][c].w); *(u32x2_t*)(WSP(bf16_t, WS_X) + (size_t)(r0 + q) * DM + c * 256 + lane * 4) = o;
                    xv[q][c] = (f32x4_t){bflo(o.x), bfhi(o.x), bflo(o.y), bfhi(o.y)}; }
        }
        float rs[NRN];
#pragma unroll
        for (int q = 0; q < NRN; ++q) { float ss = 0.f;
#pragma unroll
            for (int c = 0; c < 4; ++c) ss += (xv[q][c].x * xv[q][c].x + xv[q][c].y * xv[q][c].y) + (xv[q][c].z * xv[q][c].z + xv[q][c].w * xv[q][c].w);
            rs[q] = ss; }
#pragma unroll
        for (int o = 1; o < 64; o <<= 1) {
#pragma unroll
            for (int q = 0; q < NRN; ++q) rs[q] += __shfl_xor(rs[q], o); }
#pragma unroll
        for (int q = 0; q < NRN; ++q) rs[q] = 1.f / sqrtf(rs[q] * (1.f / DM) + 1e-6f);
        if constexpr (MODE == 2) {
#pragma unroll
            for (int c = 0; c < 4; ++c) { const int col = c * 256 + lane * 4; const f32x4_t g = *(const f32x4_t*)(p.in[I_FNG] + col);
#pragma unroll
                for (int q = 0; q < NRN; ++q) *(f32x4_t*)(p.out + ((size_t)b * SEQ + (tt + q - CTX)) * DM + col) = xv[q][c] * rs[q] * g; }
        } else {
            const float* sh = mod_ptr(p, layer, j, 0); const float* sc = mod_ptr(p, layer, j, 1); const float* g1 = p.in[I_N1G] + (size_t)layer * DM;
#pragma unroll
            for (int c = 0; c < 4; ++c) { const int col = c * 256 + lane * 4;
                const f32x4_t g = *(const f32x4_t*)(g1 + col), s1v = *(const f32x4_t*)(sc + col), s0v = *(const f32x4_t*)(sh + col);
                const f32x4_t gs = g * (s1v + 1.f);
#pragma unroll
                for (int q = 0; q < NRN; ++q) { const f32x4_t v = xv[q][c] * rs[q] * gs + s0v;
                    u32x2_t o; o.x = pk2(v.x, v.y); o.y = pk2(v.z, v.w); *(u32x2_t*)(WSP(bf16_t, WS_H) + (size_t)(r0 + q) * DM + col) = o; } }
        }
    }
}

constexpr int RW = 4;
__device__ __forceinline__ void thin_n2rt(const ThinCtx& t, int layer, bool dry = false, bool skip_ctx = false) {
    typedef short bf16x8_t __attribute__((ext_vector_type(8)));
    const Prm& p = t.p; const int lane = t.lane, wave = t.wave, tid = wave * 64 + lane;
    const float* g2 = p.in[I_N2G] + (size_t)layer * DM;
    LAS float* hs = (LAS float*)t.lds;
    LAS float* part = (LAS float*)(t.lds + 65536);
    LAS float* les = (LAS float*)(t.lds + MISC_OFF + 512);
    LAS int* lcnt = (LAS int*)(t.lds + MISC_OFF + 9216);
    __syncthreads();
    if (threadIdx.x < 2 * MOE_E) lcnt[threadIdx.x] = 0;
    __syncthreads();
    const int arow = lane & 15, kq = lane >> 4;
    bf16x8_t bh[4][3], bl[4][3];
    { const bf16_t* wh = WSP(const bf16_t, WS_WET) + ((size_t)(layer * 2 + 0) * WET_ROWS + arow) * DM + 128 * wave + 8 * kq; const bf16_t* wl = wh + (size_t)WET_ROWS * DM;
#pragma unroll
      for (int ks = 0; ks < 4; ++ks)
#pragma unroll
        for (int nt = 0; nt < 3; ++nt) { bh[ks][nt] = *(const bf16x8_t*)(wh + 16 * nt * DM + 32 * ks); bl[ks][nt] = *(const bf16x8_t*)(wl + 16 * nt * DM + 32 * ks); } }
    u32x2_t xn[2][4];
#define N2RT_LOAD(bi_) do { if ((bi_) < R / 16 && !(skip_ctx && ((bi_) * 16) % TPB < CTX)) { _Pragma("unroll") for (int q = 0; q < 2; ++q) _Pragma("unroll") for (int c = 0; c < 4; ++c) \
        xn[q][c] = *(const u32x2_t*)(WSP(const bf16_t, WS_X) + (size_t)((bi_) * 16 + 2 * wave + q) * DM + c * 256 + lane * 4); } } while (0)
    N2RT_LOAD((int)blockIdx.x);
    for (int bi = blockIdx.x; bi < R / 16; bi += gridDim.x) {
        const int r0 = bi * 16, b = r0 / TPB, tt = r0 % TPB; const int j = tt < CTX ? NB : b;
        if (skip_ctx && tt < CTX) { N2RT_LOAD(bi + (int)gridDim.x); continue; }
        {
            const float* sh = mod_ptr(p, layer, j, 3); const float* sc = mod_ptr(p, layer, j, 4);
            f32x4_t xv[2][4], gm[4], s0m[4]; float rs[2];
#pragma unroll
            for (int q = 0; q < 2; ++q)
#pragma unroll
                for (int c = 0; c < 4; ++c) { const u32x2_t xb = xn[q][c]; xv[q][c] = (f32x4_t){bflo(xb.x), bfhi(xb.x), bflo(xb.y), bfhi(xb.y)}; }
            N2RT_LOAD(bi + (int)gridDim.x);
#pragma unroll
            for (int c = 0; c < 4; ++c) { const int col = c * 256 + lane * 4; gm[c] = *(const f32x4_t*)(g2 + col) * (*(const f32x4_t*)(sc + col) + 1.f); s0m[c] = *(const f32x4_t*)(sh + col); }
#pragma unroll
            for (int q = 0; q < 2; ++q) { float ss = 0.f;
#pragma unroll
                for (int c = 0; c < 4; ++c) ss += (xv[q][c].x * xv[q][c].x + xv[q][c].y * xv[q][c].y) + (xv[q][c].z * xv[q][c].z + xv[q][c].w * xv[q][c].w);
                rs[q] = ss; }
#pragma unroll
            for (int o = 1; o < 64; o <<= 1) {
#pragma unroll
                for (int q = 0; q < 2; ++q) rs[q] += __shfl_xor(rs[q], o); }
#pragma unroll
            for (int q = 0; q < 2; ++q) { const float rq = 1.f / sqrtf(rs[q] * (1.f / DM) + 1e-6f);
#pragma unroll
                for (int c = 0; c < 4; ++c) { const int col = c * 256 + lane * 4;
                    const f32x4_t hv = xv[q][c] * rq * gm[c] + s0m[c];
                    u32x2_t o; o.x = pk2(hv.x, hv.y); o.y = pk2(hv.z, hv.w); *(u32x2_t*)(WSP(bf16_t, WS_H) + (size_t)(r0 + 2 * wave + q) * DM + col) = o;
                    *(LAS f32x4_t*)(hs + (2 * wave + q) * DM + col) = hv; } }
        }
        __syncthreads();
        {
            const LAS float* ar = hs + arow * DM + 128 * wave + 8 * kq;
            f32x4_t acc0 = {0.f, 0.f, 0.f, 0.f}, acc1 = {0.f, 0.f, 0.f, 0.f}, acc2 = {0.f, 0.f, 0.f, 0.f};
#pragma unroll
            for (int ks = 0; ks < 4; ++ks) {
                const f32x4_t a0 = *(const LAS f32x4_t*)(ar + 32 * ks), a1 = *(const LAS f32x4_t*)(ar + 32 * ks + 4);
                u32x4_t hu; hu.x = pk2(a0.x, a0.y); hu.y = pk2(a0.z, a0.w); hu.z = pk2(a1.x, a1.y); hu.w = pk2(a1.z, a1.w);
                u32x4_t lu; lu.x = pk2(a0.x - bflo(hu.x), a0.y - bfhi(hu.x)); lu.y = pk2(a0.z - bflo(hu.y), a0.w - bfhi(hu.y)); lu.z = pk2(a1.x - bflo(hu.z), a1.y - bfhi(hu.z)); lu.w = pk2(a1.z - bflo(hu.w), a1.w - bfhi(hu.w));
                const bf16x8_t ah = *reinterpret_cast<bf16x8_t*>(&hu), al = *reinterpret_cast<bf16x8_t*>(&lu);
                acc0 = __builtin_amdgcn_mfma_f32_16x16x32_bf16(ah, bh[ks][0], acc0, 0, 0, 0); acc0 = __builtin_amdgcn_mfma_f32_16x16x32_bf16(ah, bl[ks][0], acc0, 0, 0, 0); acc0 = __builtin_amdgcn_mfma_f32_16x16x32_bf16(al, bh[ks][0], acc0, 0, 0, 0);
                acc1 = __builtin_amdgcn_mfma_f32_16x16x32_bf16(ah, bh[ks][1], acc1, 0, 0, 0); acc1 = __builtin_amdgcn_mfma_f32_16x16x32_bf16(ah, bl[ks][1], acc1, 0, 0, 0); acc1 = __builtin_amdgcn_mfma_f32_16x16x32_bf16(al, bh[ks][1], acc1, 0, 0, 0);
                acc2 = __builtin_amdgcn_mfma_f32_16x16x32_bf16(ah, bh[ks][2], acc2, 0, 0, 0); acc2 = __builtin_amdgcn_mfma_f32_16x16x32_bf16(ah, bl[ks][2], acc2, 0, 0, 0); acc2 = __builtin_amdgcn_mfma_f32_16x16x32_bf16(al, bh[ks][2], acc2, 0, 0, 0);
            }
#pragma unroll
            for (int r = 0; r < 4; ++r) { LAS float* pr = part + (wave * 16 + 4 * kq + r) * WET_ROWS; pr[arow] = acc0[r]; pr[16 + arow] = acc1[r]; pr[32 + arow] = acc2[r]; }
        }
        __syncthreads();
        for (int o = tid; o < 16 * (MOE_E + MOE_G); o += NTHR) { const int row = o / (MOE_E + MOE_G), e = o % (MOE_E + MOE_G);
            float s = e < MOE_E ? p.in[I_MBE][layer * MOE_E + e] : p.in[I_MBG][layer * MOE_G + (e - MOE_E)];
#pragma unroll
            for (int w = 0; w < 8; ++w) s += part[(w * 16 + row) * WET_ROWS + e];
            les[row * WET_ROWS + e] = s; }
        __syncthreads();
        if (tid < 16 && !dry) {
            const int q = tid;
            float lg[MOE_G];
#pragma unroll
            for (int i = 0; i < MOE_G; ++i) lg[i] = les[q * WET_ROWS + MOE_E + i];
            int gi = 0; float gm = lg[0];
#pragma unroll
            for (int i = 1; i < MOE_G; ++i) if (lg[i] > gm) { gm = lg[i]; gi = i; }
            float gs = 0.f;
#pragma unroll
            for (int i = 0; i < MOE_G; ++i) gs += expf(lg[i] - gm);
            const float g_w = 1.f / gs;
            float el[MOE_EPG];
#pragma unroll
            for (int i = 0; i < MOE_EPG; ++i) el[i] = les[q * WET_ROWS + gi * MOE_EPG + i];
            int i0 = 0; float m0 = el[0];
#pragma unroll
            for (int i = 1; i < MOE_EPG; ++i) if (el[i] > m0) { m0 = el[i]; i0 = i; }
            int i1 = -1; float m1 = -3.4e38f;
#pragma unroll
            for (int i = 0; i < MOE_EPG; ++i) if (i != i0 && el[i] > m1) { m1 = el[i]; i1 = i; }
            const float p1 = expf(m1 - m0);
            const float w0 = g_w / (1.f + p1), w1 = g_w * p1 / (1.f + p1);
            const int e0 = gi * MOE_EPG + i0, e1 = gi * MOE_EPG + i1;
            const int k0 = atomicAdd((int*)&lcnt[e0], 1), k1 = atomicAdd((int*)&lcnt[e1], 1);
            int* ro = WSP(int, WS_ROUTE) + (size_t)(r0 + q) * 8;
            ro[0] = e0; ro[1] = e1; ro[2] = k0; ro[3] = k1; ro[4] = __float_as_int(w0); ro[5] = __float_as_int(w1);
        }
    }
#undef N2RT_LOAD
    asm volatile("s_waitcnt vmcnt(0) lgkmcnt(0)" ::: "memory");
    __syncthreads();
    if (!dry && threadIdx.x < MOE_E) { const int n = lcnt[threadIdx.x]; lcnt[MOE_E + threadIdx.x] = n ? atomicAdd(WSP(int, WS_CNT) + layer * MOE_E + threadIdx.x, n) : 0; }
    __syncthreads();
    if (!dry && tid < 16) for (int bi0 = blockIdx.x; bi0 < R / 16; bi0 += 4 * gridDim.x) {
        int e0[4], e1[4], k0[4], k1[4]; bool ok[4];
#pragma unroll
        for (int i = 0; i < 4; ++i) { const int bi = bi0 + i * (int)gridDim.x, r = bi * 16 + tid; ok[i] = bi < R / 16 && !(skip_ctx && r % TPB < CTX);
            if (ok[i]) { const int* ro = WSP(const int, WS_ROUTE) + (size_t)r * 8; e0[i] = ro[0]; e1[i] = ro[1]; k0[i] = ro[2]; k1[i] = ro[3]; } }
#pragma unroll
        for (int i = 0; i < 4; ++i) if (ok[i]) { const int r = (bi0 + i * (int)gridDim.x) * 16 + tid; int* ro = WSP(int, WS_ROUTE) + (size_t)r * 8;
            const int a0 = k0[i] + lcnt[MOE_E + e0[i]], a1 = k1[i] + lcnt[MOE_E + e1[i]];
            ro[2] = a0; ro[3] = a1; WSP(int, WS_LIST)[(size_t)e0[i] * CAPL + a0] = r; WSP(int, WS_LIST)[(size_t)e1[i] * CAPL + a1] = r; }
    }
}
__device__ __forceinline__ void thin_gather(const ThinCtx& t, int layer) {
    const Prm& p = t.p; const int lane = t.lane;
    LAS int* offs = (LAS int*)(t.lds + MISC_OFF + 128);
    __syncthreads();
    if (threadIdx.x < 64) { const int l = threadIdx.x; const int* cnt = WSP(const int, WS_CNT) + layer * MOE_E; const int tl = l < MOE_E ? (cnt[l] + MOE_MT - 1) / MOE_MT * MOE_MT : 0; int v = tl;
#pragma unroll
        for (int o = 1; o < 64; o <<= 1) { const int tq = __shfl_up(v, o); if (l >= o) v += tq; }
        if (l < MOE_E) offs[l] = v - tl; }
    __syncthreads();
    for (int r0 = t.gw * 2; r0 < R; r0 += t.ngw * 2) {
        int slot[2][2]; u32x4_t v[2][2];
#pragma unroll
        for (int q = 0; q < 2; ++q) { int* ro = WSP(int, WS_ROUTE) + (size_t)(r0 + q) * 8;
            const int e0 = ro[0], e1 = ro[1], k0 = ro[2], k1 = ro[3];
            slot[q][0] = offs[e0] + k0; slot[q][1] = offs[e1] + k1;
            const bf16_t* h = WSP(const bf16_t, WS_H) + (size_t)(r0 + q) * DM;
            v[q][0] = *(const u32x4_t*)(h + lane * 8); v[q][1] = *(const u32x4_t*)(h + 512 + lane * 8); }
#pragma unroll
        for (int q = 0; q < 2; ++q) { int* ro = WSP(int, WS_ROUTE) + (size_t)(r0 + q) * 8;
            if (lane == 0) { ro[6] = slot[q][0]; ro[7] = slot[q][1]; }
#pragma unroll
            for (int jj = 0; jj < 2; ++jj) { bf16_t* xb = WSP(bf16_t, WS_XB) + (size_t)slot[q][jj] * DM; *(u32x4_t*)(xb + lane * 8) = v[q][0]; *(u32x4_t*)(xb + 512 + lane * 8) = v[q][1]; } }
    }
}
__device__ __forceinline__ void thin_even_mid(const ThinCtx& t, int ih, bool do_rope) {
    const Prm& p = t.p; const int lane = t.lane;
    const float* tab = WSP(const float, WS_ROPE);
    const float* cw = p.in[I_BCONV] + (size_t)ih * 3 * CW;
    if (do_rope) {
        const int blk = lane >> 1, sub = lane & 1, axis = blk & 1;
        for (int r0 = t.gw * 4; r0 < R; r0 += t.ngw * 4) {
            const int tt = r0 % TPB; if (tt < CTX) continue;
            u32x4_t a1[4], a2[4]; f32x4_t tb[4][4];
#pragma unroll
            for (int q = 0; q < 4; ++q) { const int pos = tt + q - CTX; const int pv = axis == 0 ? pos / GRID_W : pos % GRID_W;
                const bf16_t* q1 = WSP(const bf16_t, WS_QKVC) + (size_t)(r0 + q) * ABIN + blk * 32 + sub * 8;
                a1[q] = *(const u32x4_t*)q1; a2[q] = *(const u32x4_t*)(q1 + 16);
                const float* tp = tab + ((size_t)pv * 16 + sub * 8) * 2;
#pragma unroll
                for (int i = 0; i < 4; ++i) tb[q][i] = *(const f32x4_t*)(tp + 4 * i); }
#pragma unroll
            for (int q = 0; q < 4; ++q) { float x1[8], x2[8], o1[8], o2[8]; unpack8f(a1[q], x1); unpack8f(a2[q], x2);
#pragma unroll
                for (int i = 0; i < 8; ++i) { const float cs = tb[q][i >> 1][(i & 1) * 2], sn = tb[q][i >> 1][(i & 1) * 2 + 1]; o1[i] = x1[i] * cs - x2[i] * sn; o2[i] = x2[i] * cs + x1[i] * sn; }
                bf16_t* q1 = WSP(bf16_t, WS_QKVC) + (size_t)(r0 + q) * ABIN + blk * 32 + sub * 8;
                *(u32x4_t*)q1 = pack8f(o1); *(u32x4_t*)(q1 + 16) = pack8f(o2); }
        }
    }
    {
        const int ch = lane * 8;
        float w0[8], w1[8], w2[8];
#pragma unroll
        for (int i = 0; i < 8; ++i) { w0[i] = cw[ch + i]; w1[i] = cw[CW + ch + i]; w2[i] = cw[2 * CW + ch + i]; }
        for (int r0 = t.gw * 8; r0 < R; r0 += t.ngw * 8) {
            const int tt = r0 % TPB; const bool first = (tt == 0) || (tt == CTX), last = (tt + 8 == CTX) || (tt + 8 == TPB);
            const bf16_t* row = WSP(const bf16_t, WS_QKVC) + (size_t)r0 * ABIN + 3 * DW + ch;
            u32x4_t gcv[10], xcv[10], gbv[8];
#pragma unroll
            for (int q = 0; q < 10; ++q) { const bool ok = !((q == 0 && first) || (q == 9 && last)); const bf16_t* rp = row + (long)(q - 1) * ABIN;
                gcv[q] = ok ? *(const u32x4_t*)(rp + CW) : (u32x4_t){0u, 0u, 0u, 0u}; xcv[q] = ok ? *(const u32x4_t*)(rp + 2 * CW) : (u32x4_t){0u, 0u, 0u, 0u}; }
#pragma unroll
            for (int q = 0; q < 8; ++q) gbv[q] = *(const u32x4_t*)(row + (long)q * ABIN);
            float u0[8], u1[8], u2[8], gc[8], xc[8];
            unpack8f(gcv[0], gc); unpack8f(xcv[0], xc);
#pragma unroll
            for (int i = 0; i < 8; ++i) u0[i] = gc[i] * xc[i];
            unpack8f(gcv[1], gc); unpack8f(xcv[1], xc);
#pragma unroll
            for (int i = 0; i < 8; ++i) u1[i] = gc[i] * xc[i];
#pragma unroll
            for (int q = 0; q < 8; ++q) { unpack8f(gcv[q + 2], gc); unpack8f(xcv[q + 2], xc);
                float gb[8], o[8]; unpack8f(gbv[q], gb);
#pragma unroll
                for (int i = 0; i < 8; ++i) { u2[i] = gc[i] * xc[i]; o[i] = gb[i] * (w0[i] * u0[i] + w1[i] * u1[i] + w2[i] * u2[i]); u0[i] = u1[i]; u1[i] = u2[i]; }
                *(u32x4_t*)(WSP(bf16_t, WS_CAT) + (size_t)(r0 + q) * DM + DW + ch) = pack8f(o); }
        }
    }
}
__device__ __forceinline__ void thin_combine(const ThinCtx& t, int ih) {
    const Prm& p = t.p; const int lane = t.lane;
    const float lam = WSP(const float, WS_LAM)[ih], li = lam_init_of(ih);
    const float* sg = p.in[I_SUBLN] + (size_t)ih * VD;
    for (int r = t.gw; r < R; r += t.ngw) {
        const int h = lane >> 4, d0 = (lane & 15) * 8;
        const float* o1 = WSP(const float, WS_O12) + ((size_t)r * 2 * NDH + 2 * h) * VD + d0; const float* o2 = o1 + VD;
        float v[8]; float ss = 0.f;
        const f32x4_t a0 = *(const f32x4_t*)o1, a1 = *(const f32x4_t*)(o1 + 4), b0 = *(const f32x4_t*)o2, b1 = *(const f32x4_t*)(o2 + 4);
#pragma unroll
        for (int i = 0; i < 4; ++i) { v[i] = a0[i] - lam * b0[i]; v[4 + i] = a1[i] - lam * b1[i]; }
#pragma unroll
        for (int i = 0; i < 8; ++i) ss += v[i] * v[i];
#pragma unroll
        for (int o = 1; o < 16; o <<= 1) ss += __shfl_xor(ss, o);
        const float rs = (1.f - li) / sqrtf(ss * (1.f / VD) + 1e-6f);
#pragma unroll
        for (int i = 0; i < 8; ++i) v[i] = v[i] * rs * sg[d0 + i];
        *(u32x4_t*)(WSP(bf16_t, WS_CAT) + (size_t)r * DM + h * VD + d0) = pack8f(v);
    }
}
__device__ __forceinline__ void thin_ssdconv(const ThinCtx& t, int ih) {
    const Prm& p = t.p; const int lane = t.lane;
    const float* w = p.in[I_SSDCW] + (size_t)ih * 3 * SSD_CC; const float* cb = p.in[I_SSDCB] + (size_t)ih * SSD_CC;
    constexpr int NG = SSD_CC / 512 + 1;
    for (int it = t.gw; it < (R / 16) * NG; it += t.ngw) {
        const int g = it % NG, r0 = (it / NG) * 16, tt = r0 % TPB;
        if (g == NG - 1) {
            const float bias = p.in[I_SSDDTB][(size_t)ih * 2 * SSD_H + lane]; bf16_t raw[16];
#pragma unroll
            for (int q = 0; q < 16; ++q) raw[q] = WSP(const bf16_t, WS_ZXD)[(size_t)(r0 + q) * SSD_NP + SSD_DI + SSD_CC + lane];
#pragma unroll
            for (int q = 0; q < 16; ++q) { const float v = bf2f(raw[q]) + bias; WSP(float, WS_DT)[(size_t)(r0 + q) * 2 * SSD_H + lane] = v > 20.f ? v : log1pf(expf(v)); }
            continue;
        }
        const bool first = (tt == 0) || (tt == CTX), last = (tt + 16 == CTX) || (tt + 16 == TPB);
        const int ch = g * 512 + lane * 8;
        const bf16_t* z = WSP(const bf16_t, WS_ZXD) + (size_t)r0 * SSD_NP + SSD_DI + ch;
        u32x4_t xin[18];
#pragma unroll
        for (int q = 0; q < 18; ++q) { const bool ok = !((q == 0 && first) || (q == 17 && last)); xin[q] = ok ? *(const u32x4_t*)(z + (long)(q - 1) * SSD_NP) : (u32x4_t){0u, 0u, 0u, 0u}; }
        float w0[8], w1[8], w2[8], bv[8];
#pragma unroll
        for (int i = 0; i < 8; ++i) { w0[i] = w[ch + i]; w1[i] = w[SSD_CC + ch + i]; w2[i] = w[2 * SSD_CC + ch + i]; bv[i] = cb[ch + i]; }
        float a[8], bq[8], c[8], o[8];
        unpack8f(xin[0], a); unpack8f(xin[1], bq);
#pragma unroll
        for (int q = 0; q < 16; ++q) { unpack8f(xin[q + 2], c);
#pragma unroll
            for (int i = 0; i < 8; ++i) { o[i] = silu_fast(w0[i] * a[i] + w1[i] * bq[i] + w2[i] * c[i] + bv[i]); a[i] = bq[i]; bq[i] = c[i]; }
            *(u32x4_t*)(WSP(bf16_t, WS_XBC) + (size_t)(r0 + q) * SSD_CC + ch) = pack8f(o); }
    }
}
__device__ __forceinline__ void thin_gnorm(const ThinCtx& t, int ih) {
    const Prm& p = t.p; const int lane = t.lane;
    const float* Dk = p.in[I_SSDD] + (size_t)ih * SSD_H; const float* ng = p.in[I_SSDNG] + (size_t)ih * SSD_DI;
    float dk[SSD_G];
#pragma unroll
    for (int g = 0; g < SSD_G; ++g) dk[g] = Dk[(g * 512 + lane * 8) / SSD_P];
    for (int r = t.gw; r < R; r += t.ngw) {
        u32x4_t yf[SSD_G], yb[SSD_G], xs[SSD_G], zz[SSD_G];
#pragma unroll
        for (int g = 0; g < SSD_G; ++g) { const int col = g * 512 + lane * 8;
            yf[g] = *(const u32x4_t*)(WSP(const bf16_t, WS_YS) + (size_t)r * SSD_DI + col); yb[g] = *(const u32x4_t*)(WSP(const bf16_t, WS_YS) + (size_t)(R + r) * SSD_DI + col);
            xs[g] = *(const u32x4_t*)(WSP(const bf16_t, WS_XBC) + (size_t)r * SSD_CC + col); zz[g] = *(const u32x4_t*)(WSP(const bf16_t, WS_ZXD) + (size_t)r * SSD_NP + col); }
        float v[SSD_G][8], ss[SSD_G];
#pragma unroll
        for (int g = 0; g < SSD_G; ++g) { float a[8], bq[8], c[8], d[8]; unpack8f(yf[g], a); unpack8f(yb[g], bq); unpack8f(xs[g], c); unpack8f(zz[g], d); float s = 0.f;
#pragma unroll
            for (int i = 0; i < 8; ++i) { v[g][i] = (a[i] + bq[i] + c[i] * dk[g]) * silu_fast(d[i]); s += v[g][i] * v[g][i]; }
            ss[g] = s; }
#pragma unroll
        for (int o = 1; o < 64; o <<= 1) {
#pragma unroll
            for (int g = 0; g < SSD_G; ++g) ss[g] += __shfl_xor(ss[g], o); }
#pragma unroll
        for (int g = 0; g < SSD_G; ++g) { const int col = g * 512 + lane * 8; const f32x4_t n0 = *(const f32x4_t*)(ng + col), n1 = *(const f32x4_t*)(ng + col + 4);
            const float rs = 1.f / sqrtf(ss[g] * (1.f / 512.f) + 1e-6f); float o[8];
#pragma unroll
            for (int i = 0; i < 8; ++i) o[i] = v[g][i] * rs * (i < 4 ? n0[i] : n1[i - 4]);
            *(u32x4_t*)(WSP(bf16_t, WS_YN) + (size_t)r * SSD_DI + col) = pack8f(o); }
    }
}
#ifndef DBL_MASK
#define DBL_MASK 0
#endif
#define DBL(x) ((DBL_MASK >> (x)) & 1)
#ifndef OPT_GEMM
#define OPT_GEMM 1
#endif
#ifndef OPT_ATTN
#define OPT_ATTN 1
#endif
#ifndef OPT_SSD
#define OPT_SSD 1
#endif
struct DevRunner {
    Prm p; XcdBarrier bar; LAS unsigned char* lds;
    template <int ST> __device__ __forceinline__ void naive(int layer) {
        Prm p = this->p; asm volatile("" : "+s"(p.ws)); p.ws = (unsigned char*)(__attribute__((address_space(1))) unsigned char*)p.ws;
        const size_t n = stage_items(ST);
        for (size_t i = (size_t)blockIdx.x * NTHR + threadIdx.x; i < n; i += (size_t)gridDim.x * NTHR) stage_item<ST>(p, layer, i);
    }
    __device__ __forceinline__ void moe_pref(int layer) {
        LAS int* pref = (LAS int*)(lds + MISC_OFF + 128);
        Prm p = this->p; asm volatile("" : "+s"(p.ws)); p.ws = (unsigned char*)(__attribute__((address_space(1))) unsigned char*)p.ws;
        __syncthreads();
        if (threadIdx.x < 64) { const int l = threadIdx.x; const int* cnt = WSP(const int, WS_CNT) + layer * MOE_E; const int tl = l < MOE_E ? (cnt[l] + MOE_MT - 1) / MOE_MT : 0; int v = tl;
#pragma unroll
            for (int o = 1; o < 64; o <<= 1) { const int tq = __shfl_up(v, o); if (l >= o) v += tq; }
            if (l < MOE_E) { pref[l] = v - tl; pref[MOE_E + 1 + l] = cnt[l]; } if (l == MOE_E - 1) pref[MOE_E] = v; }
        __syncthreads();
    }
    template <int ST> __device__ __forceinline__ void go(int layer) {
        const int ih = layer / 2; const int G = gridDim.x, c = blockIdx.x;
        Prm p = this->p; asm volatile("" : "+s"(p.ws)); p.ws = (unsigned char*)(__attribute__((address_space(1))) unsigned char*)p.ws;
        if constexpr (OPT_GEMM && ST == ST_G1E) {
            pg8::Gemm g{WSP(const bf16_t, WS_H), WSP(const bf16_t, WS_WABIN) + (size_t)ih * ABIN * DM, R, ABIN, DM}; pg8::StaticOrder S; S.init(R, ABIN, G, c);
            pg8::EpiStoreRope E{WSP(bf16_t, WS_QKVC), ABIN, WSP(const float, WS_ROPE), 2 * DW / 256}; pg8::gemm_phase<pg8::EpiStoreRope, pg8::StaticOrder, true, true>(lds, g, S, E);
        } else if constexpr (OPT_GEMM && ST == ST_G2E) {
            pg8::Gemm g{WSP(const bf16_t, WS_CAT), WSP(const bf16_t, WS_WABOUT) + (size_t)ih * DM * DM, R, DM, DM}; pg8::StaticOrder S; S.init(R, DM, G, c);
            pg8::EpiResid E{WSP(bf16_t, WS_X), WSP(const float, WS_MODS) + (size_t)layer * (NB + 1) * 6 * DM, 2, DM}; pg8::gemm_phase<pg8::EpiResid, pg8::StaticOrder, true, true>(lds, g, S, E);
        } else if constexpr (OPT_GEMM && ST == ST_G1O) {
            pg8::Gemm g{WSP(const bf16_t, WS_H), WSP(const bf16_t, WS_WSIN) + (size_t)ih * SSD_NP * DM, R, SSD_NP, DM}; pg8::StaticOrder S; S.init(R, SSD_NP, G, c);
            pg8::EpiStore E{WSP(bf16_t, WS_ZXD), SSD_NP}; pg8::gemm_phase<pg8::EpiStore, pg8::StaticOrder, true, true>(lds, g, S, E);
        } else if constexpr (OPT_GEMM && ST == ST_G2O) {
            pg8::Gemm g{WSP(const bf16_t, WS_YN), WSP(const bf16_t, WS_WSOUT) + (size_t)ih * DM * SSD_DI, R, DM, SSD_DI};
            pg8::EpiResid E{WSP(bf16_t, WS_X), WSP(const float, WS_MODS) + (size_t)layer * (NB + 1) * 6 * DM, 2, DM};
            if (layer == DEPTH - 1) { pg8::LatentOrder S{G, c, DM / 256}; pg8::gemm_phase<pg8::EpiResid, pg8::LatentOrder, true, true>(lds, g, S, E); }
            else { pg8::StaticOrder S; S.init(R, DM, G, c); pg8::gemm_phase<pg8::EpiResid, pg8::StaticOrder, true, true>(lds, g, S, E); }
        } else if constexpr (OPT_GEMM && ST == ST_MOE1) {
            moe_pref(layer);
            const LAS int* pref = (const LAS int*)(lds + MISC_OFF + 128);
            const int vcu = (G % 8 == 0) ? (c % 8) * (G / 8) + c / 8 : c;
            pg8::MoeOrder S{pref, G, vcu, 2 * MOE_HID / 256};
            LAS int* rowtok = (LAS int*)(lds + MISC_OFF + 9472);
            { int tix = threadIdx.x; asm volatile("" : "+v"(tix));
              int tk[4]; bool has[4];
#pragma unroll
              for (int i = 0; i < 4; ++i) { pg8::Unit u; has[i] = S.next(i, u); tk[i] = 0;
                  if (has[i] && tix < 256) { int e = 0;
#pragma unroll
                      for (int q = 1; q < MOE_E; ++q) e = (u.pm >= pref[q]) ? q : e;
                      const int lr = (u.pm - pref[e]) * 256 + tix;
                      if (lr < pref[MOE_E + 1 + e]) tk[i] = WSP(const int, WS_LIST)[(size_t)e * CAPL + lr]; } }
#pragma unroll
              for (int i = 0; i < 4; ++i) if (has[i] && tix < 256) rowtok[i * 256 + tix] = tk[i]; }
            __syncthreads();
            pg8::Gemm g{WSP(const bf16_t, WS_H), WSP(const bf16_t, WS_W1), NSLOT, 2 * MOE_HID, DM};
            pg8::EpiSwiGLU E{WSP(bf16_t, WS_ACT), MOE_HID}; pg8::gemm_phase<pg8::EpiSwiGLU, pg8::MoeOrder, true, true, true>(lds, g, S, E, rowtok);
        } else if constexpr (OPT_GEMM && ST == ST_MOE2) {
            moe_pref(layer);
            pg8::Gemm g{WSP(const bf16_t, WS_ACT), WSP(const bf16_t, WS_W2), NSLOT, DM, MOE_HID}; pg8::MoeOrder S{(const LAS int*)(lds + MISC_OFF + 128), G, (G % 8 == 0) ? (c % 8) * (G / 8) + c / 8 : c, DM / 256};
            pg8::EpiStore E{WSP(bf16_t, WS_YB), DM}; pg8::gemm_phase<pg8::EpiStore, pg8::MoeOrder, true, true>(lds, g, S, E);
        } else if constexpr (OPT_ATTN && ST == ST_ATTN) {
            const int vcu = (G % 8 == 0) ? (c % 8) * (G / 8) + c / 8 : c;
            constexpr int NQB = SEQ / 256, NLAT = NB * NDH * NQB, NUNIT = NLAT + NB * NDH;
#define ATT_DECODE(uu) int b_, h_, row0_, seq_; { int u2 = (uu); asm volatile("" : "+s"(u2)); if (u2 < NLAT) { const int qb = u2 % NQB; h_ = (u2 / NQB) % NDH; b_ = u2 / (NQB * NDH); row0_ = b_ * TPB + CTX + qb * 256; seq_ = TPB; } \
                else { const int v = u2 - NLAT; h_ = v % NDH; b_ = v / NDH; row0_ = b_ * TPB; seq_ = CTX; } }
            for (int u = vcu; u < NUNIT; u += G) {
#pragma unroll 1
                for (int cc = 0; cc < 2; ++cc) {
                    ATT_DECODE(u);
                    const bf16_t* Q = WSP(const bf16_t, WS_QKVC); float* O = WSP(float, WS_O12); const size_t kv0 = (size_t)b_ * TPB * ABIN;
                    __syncthreads();
                    att::attn_dense_body(Q + (size_t)row0_ * ABIN + h_ * VD + cc * QKD, Q + kv0 + DW + h_ * VD, Q + kv0 + 2 * DW + h_ * VD,
                                         O + (size_t)row0_ * att::LDO + (2 * h_ + cc) * VD, seq_, (char*)lds, cc * QKD * 2);
                }
                { ATT_DECODE(u); (void)seq_; (void)b_;
                  float* O = WSP(float, WS_O12);
                  att::attn_combine(O + (size_t)row0_ * att::LDO + 2 * h_ * VD, O + (size_t)row0_ * att::LDO + (2 * h_ + 1) * VD, WSP(const float, WS_LAM)[ih], 1.f - lam_init_of(ih),
                                    p.in[I_SUBLN] + (size_t)ih * VD, WSP(bf16_t, WS_CAT) + (size_t)row0_ * DM + h_ * VD, DM); }
            }
#undef ATT_DECODE
        } else if constexpr (OPT_SSD && ST == ST_SSD) {
            const int vcu = (G % 8 == 0) ? (c % 8) * (G / 8) + c / 8 : c;
            for (int u = vcu; u < NB * 2 * SSD_H; u += G) { __syncthreads(); ssd::ssd_unit(p, ih, u / (2 * SSD_H), (u / SSD_H) % 2, u % SSD_H, lds); }
        } else naive<ST>(layer);
    }
    __device__ __forceinline__ void sync() { xcd_barrier(bar); if (DBL(4)) xcd_barrier(bar); }
    __device__ __forceinline__ ThinCtx tc() const {
        ThinCtx t; t.p = this->p; asm volatile("" : "+s"(t.p.ws)); t.p.ws = (unsigned char*)(GAS unsigned char*)t.p.ws;
        int tid = threadIdx.x; asm volatile("" : "+v"(tid));
        t.lds = lds; t.wave = __builtin_amdgcn_readfirstlane(tid >> 6); t.lane = tid & 63; t.gw = blockIdx.x * (NTHR / 64) + t.wave; t.ngw = gridDim.x * (NTHR / 64); return t;
    }
};
template <int layer> __device__ __forceinline__ void mk_layer(DevRunner& run) {
    constexpr int ih = layer / 2;
    if constexpr (layer > 0) { thin_moe_w(run.tc(), layer); if (DBL(5)) thin_moe_w(run.tc(), layer); thin_resnorm<1>(run.tc(), layer); run.sync(); }
    if constexpr (layer % 2 == 0) {
        run.template go<ST_G1E>(layer); if (DBL(2)) run.template go<ST_G1E>(layer); run.sync();
        {
            ThinCtx t = run.tc(); const int G_ = (int)gridDim.x, c_ = (int)blockIdx.x, vcu_ = (G_ % 8 == 0) ? (c_ % 8) * (G_ / 8) + c_ / 8 : c_;
            if (G_ > 2 * NB * NDH) { t.gw = (vcu_ - NB * NDH) * (NTHR / 64) + t.wave; t.ngw = (G_ - NB * NDH) * (NTHR / 64); if (vcu_ >= NB * NDH) thin_even_mid(t, ih, false); }
            else thin_even_mid(t, ih, false);
            if (DBL(6)) thin_even_mid(run.tc(), ih, false);
        }
        run.template go<ST_ATTN>(layer); if (DBL(0)) run.template go<ST_ATTN>(layer); run.sync();
        run.template go<ST_G2E>(layer); run.sync();
    } else {
        run.template go<ST_G1O>(layer); if (DBL(2)) run.template go<ST_G1O>(layer); run.sync();
        thin_ssdconv(run.tc(), ih); if (DBL(6)) thin_ssdconv(run.tc(), ih); run.sync();
        run.template go<ST_SSD>(layer); if (DBL(1)) run.template go<ST_SSD>(layer); run.sync();
        thin_gnorm(run.tc(), ih); if (DBL(6)) thin_gnorm(run.tc(), ih); run.sync();
        run.template go<ST_G2O>(layer); run.sync();
    }
    thin_n2rt(run.tc(), layer, false, layer == DEPTH - 1); run.sync();
    run.template go<ST_MOE1>(layer); if (DBL(3)) run.template go<ST_MOE1>(layer); run.sync();
    run.template go<ST_MOE2>(layer); if (DBL(3)) run.template go<ST_MOE2>(layer); run.sync();
}
__device__ __forceinline__ void mk_program(DevRunner& run) {
    thin_mods(run.tc()); thin_prolog_w(run.tc()); thin_moe_w(run.tc(), 0); run.template naive<ST_MISC>(0);
    if (DBL(5)) { thin_prolog_w(run.tc()); thin_moe_w(run.tc(), 0); }
    if (DBL(7)) { thin_mods(run.tc()); }
    run.sync();
    thin_resnorm<0>(run.tc(), 0); run.sync();
    mk_layer<0>(run); mk_layer<1>(run); mk_layer<2>(run); mk_layer<3>(run);
    thin_resnorm<2>(run.tc(), DEPTH);
}

__global__ void __launch_bounds__(NTHR, 2) mk_fwd(Prm p) {
    extern __shared__ __attribute__((aligned(16))) unsigned char lds[];
    for (int u = threadIdx.x; u < (LDS_BYTES - LDSCTL_OFF) / 4; u += NTHR) ((LAS unsigned*)((LAS unsigned char*)lds + LDSCTL_OFF))[u] = 0u;
    __syncthreads();
    DevRunner run; run.p = p; run.lds = (LAS unsigned char*)lds;
    run.bar = xcd_barrier_post((unsigned*)(p.ws + WS_CTL) + CW_BAR, (volatile LAS unsigned*)((LAS unsigned char*)lds + MISC_OFF) + 8);
    mk_program(run);
}

extern "C" void kernel_launch(void* const* d_in, const int* in_sizes, int n_in, void* d_out, int out_size, void* d_ws, size_t ws_size, hipStream_t stream) {
    static int grid = 0;
    if (grid == 0) {
        if (n_in != N_IN || ws_size < WS_END || out_size != NB * SEQ * DM) { fprintf(stderr, "kernel_launch: bad args n_in %d ws %zu need %zu out %d\n", n_in, ws_size, (size_t)WS_END, out_size); grid = -1; return; }
        int dev = 0, cus = 0, per_cu = 0;
        if (hipGetDevice(&dev) != hipSuccess || hipDeviceGetAttribute(&cus, hipDeviceAttributeMultiprocessorCount, dev) != hipSuccess) { grid = -1; return; }
        if (hipFuncSetAttribute((const void*)mk_fwd, hipFuncAttributeMaxDynamicSharedMemorySize, LDS_BYTES) != hipSuccess) { fprintf(stderr, "kernel_launch: hipFuncSetAttribute failed\n"); grid = -1; return; }
        if (hipOccupancyMaxActiveBlocksPerMultiprocessor(&per_cu, (const void*)mk_fwd, NTHR, LDS_BYTES) != hipSuccess || per_cu < 1) { fprintf(stderr, "kernel_launch: occupancy query says %d\n", per_cu); (void)hipGetLastError(); grid = -1; return; }
        grid = cus;
    }
    if (grid < 0) return;
    if (hipMemsetAsync((char*)d_ws + WS_CTL, 0, CTL_BYTES, stream) != hipSuccess) return;
    Prm p{};
    for (int i = 0; i < N_IN; ++i) p.in[i] = (const float*)d_in[i];
    p.out = (float*)d_out; p.ws = (unsigned char*)d_ws;
    hipLaunchKernelGGL(mk_fwd, dim3(grid), dim3(NTHR), LDS_BYTES, stream, p);
}
#endif

#if !defined(CPU_EMU) && defined(PROBE_PHASES)
#define PROBE_K(name, call) __global__ void __launch_bounds__(NTHR, 2) name(Prm p, int layer) { extern __shared__ __attribute__((aligned(16))) unsigned char lds[]; DevRunner run; run.p = p; run.lds = (LAS unsigned char*)lds; run.bar.bar = nullptr; run.bar.x = 0; run.bar.st = nullptr; call; }
PROBE_K(pk_prolog_w, thin_prolog_w(run.tc()))
PROBE_K(pk_moe_w, thin_moe_w(run.tc(), layer))
PROBE_K(pk_resnorm0, thin_resnorm<0>(run.tc(), layer))
PROBE_K(pk_resnorm1, thin_resnorm<1>(run.tc(), layer))
PROBE_K(pk_resnorm2, thin_resnorm<2>(run.tc(), layer))
PROBE_K(pk_n2rt, thin_n2rt(run.tc(), layer))
PROBE_K(pk_gather, thin_gather(run.tc(), layer))
PROBE_K(pk_even_mid, thin_even_mid(run.tc(), layer, true))
PROBE_K(pk_combine, thin_combine(run.tc(), layer))
PROBE_K(pk_ssdconv, thin_ssdconv(run.tc(), layer))
PROBE_K(pk_gnorm, thin_gnorm(run.tc(), layer))
PROBE_K(pk_g1e, run.template go<ST_G1E>(0))
PROBE_K(pk_g2e, run.template go<ST_G2E>(0))
PROBE_K(pk_moe1, run.template go<ST_MOE1>(0))
PROBE_K(pk_attn, run.template go<ST_ATTN>(0))
PROBE_K(pk_ssd_naive, run.template naive<ST_SSD>(1))
PROBE_K(pk_ssd, run.template go<ST_SSD>(1))
#endif
```
